# Optimizing an MI355X kernel written in HIP

```python
import math
import jax, jax.numpy as jnp
from jax import lax
import numpy as np

D_MODEL = 1024
BATCH = 32
SEQ = 256
DEPTH = 2
DEC_BATCH = 8
DEC_SEQ = 4096
PAST_LEN = 256

GRID_W = 64
HEAD_DIM = 64
A_HEADS = 8
A_KV_HEADS = 2
A_GROUP = A_HEADS // A_KV_HEADS
A_WIDTH = A_HEADS * HEAD_DIM
A_KV_WIDTH = A_KV_HEADS * HEAD_DIM
WINDOW = 128
ATTN_BLOCK = 128
ROPE_BASE = 10000.0
B_GROUPS = 4
B_GROUP_DIM = 64
B_WIDTH = B_GROUPS * B_GROUP_DIM
SGU_CHUNK = 128
C_HEADS = 4
C_HEAD_DIM = 64
C_WIDTH = C_HEADS * C_HEAD_DIM
CONV_K = 5
GDN_CHUNK = 64
N_DIRS = 2
D_MIX = A_WIDTH + B_WIDTH + C_WIDTH
IN_SPLITS = (A_WIDTH, A_KV_WIDTH, A_KV_WIDTH, A_WIDTH,
             B_WIDTH, B_WIDTH, B_WIDTH,
             C_WIDTH, C_WIDTH, C_WIDTH, N_DIRS * C_HEADS, N_DIRS * C_HEADS, C_WIDTH)
IN_COLS = sum(IN_SPLITS)
EPS = 1e-6
NEG_INF = -1e30

kernel_name = 'hybrid_flow_trunk_step'


def _rmsnorm(x, g):
    xf = x.astype(jnp.float32)
    y = xf * lax.rsqrt(jnp.mean(xf * xf, axis=-1, keepdims=True) + EPS)
    return (y * g.astype(jnp.float32)).astype(x.dtype)


def _layernorm(x, g, b):
    xf = x.astype(jnp.float32)
    xc = xf - jnp.mean(xf, axis=-1, keepdims=True)
    y = xc * lax.rsqrt(jnp.mean(xc * xc, axis=-1, keepdims=True) + EPS)
    return (y * g.astype(jnp.float32) + b.astype(jnp.float32)).astype(x.dtype)


def _l2norm(x):
    return x * lax.rsqrt(jnp.sum(x * x, axis=-1, keepdims=True) + EPS)


def _rope_2d(x):
    n = x.shape[1]
    rows = n // GRID_W
    row = jnp.repeat(jnp.arange(rows), GRID_W)
    col = jnp.tile(jnp.arange(GRID_W), rows)
    half = HEAD_DIM // 2
    nf = half // 2
    inv_freq = ROPE_BASE ** (-jnp.arange(nf, dtype=jnp.float32) / nf)
    xf = x.astype(jnp.float32)

    def rot(xa, pos):
        ang = pos.astype(jnp.float32)[:, None] * inv_freq[None, :]
        cos = jnp.cos(ang)[None, :, None, :]
        sin = jnp.sin(ang)[None, :, None, :]
        x1, x2 = xa[..., :nf], xa[..., nf:]
        return jnp.concatenate([x1 * cos - x2 * sin, x2 * cos + x1 * sin], axis=-1)

    out = jnp.concatenate([rot(xf[..., :half], row), rot(xf[..., half:], col)], axis=-1)
    return out.astype(x.dtype)


def _attend(q, k, v, mask, sink):
    s = jnp.einsum('bqhgd,bkhd->bhgqk', q, k).astype(jnp.float32) * (HEAD_DIM ** -0.5)
    s = jnp.where(mask, s, NEG_INF)
    sk = sink.astype(jnp.float32)[None, :, :, None, None]
    m = jnp.maximum(jnp.max(s, axis=-1, keepdims=True), sk)
    p = jnp.exp(s - m)
    p = p / (jnp.sum(p, axis=-1, keepdims=True) + jnp.exp(sk - m))
    return jnp.einsum('bhgqk,bkhd->bqhgd', p.astype(v.dtype), v)


def _context_attention(q, k, v, sink):
    b, s = q.shape[:2]
    nb = s // ATTN_BLOCK
    qb = jnp.moveaxis(q.reshape(b, nb, ATTN_BLOCK, A_KV_HEADS, A_GROUP, HEAD_DIM), 1, 0)
    mask = jnp.ones((ATTN_BLOCK, s), dtype=bool)
    o = lax.map(lambda qi: _attend(qi, k, v, mask, sink), qb)
    return jnp.moveaxis(o, 0, 1).reshape(b, s, A_WIDTH)


def _latent_attention(q, k, v, k_ctx, v_ctx, sink):
    b, n = q.shape[:2]
    nb = n // ATTN_BLOCK
    n_ctx = k_ctx.shape[1]
    pad = ((0, 0), (ATTN_BLOCK, ATTN_BLOCK), (0, 0), (0, 0))
    k_pad = jnp.pad(k, pad)
    v_pad = jnp.pad(v, pad)
    q_rel = jnp.arange(ATTN_BLOCK)
    k_rel = jnp.arange(3 * ATTN_BLOCK) - ATTN_BLOCK
    band = jnp.abs(q_rel[:, None] - k_rel[None, :]) <= WINDOW
    ctx_ok = jnp.ones((ATTN_BLOCK, n_ctx), dtype=bool)

    def block(i):
        start = i * ATTN_BLOCK
        qi = lax.dynamic_slice_in_dim(q, start, ATTN_BLOCK, axis=1)
        ki = lax.dynamic_slice_in_dim(k_pad, start, 3 * ATTN_BLOCK, axis=1)
        vi = lax.dynamic_slice_in_dim(v_pad, start, 3 * ATTN_BLOCK, axis=1)
        kpos = start + k_rel
        mask = band & ((kpos >= 0) & (kpos < n))[None, :]
        mask = jnp.concatenate([mask, ctx_ok], axis=1)
        keys = jnp.concatenate([ki, k_ctx.astype(ki.dtype)], axis=1)
        vals = jnp.concatenate([vi, v_ctx.astype(vi.dtype)], axis=1)
        return _attend(qi, keys, vals, mask, sink)

    o = lax.map(block, jnp.arange(nb))
    return jnp.moveaxis(o, 0, 1).reshape(b, n, A_WIDTH)


def _sgu(u, v, ln_g, ln_b, w_s, b_s):
    b, n = u.shape[:2]
    nc = n // SGU_CHUNK
    vg = _layernorm(v.reshape(b, n, B_GROUPS, B_GROUP_DIM),
                    ln_g.reshape(B_GROUPS, B_GROUP_DIM), ln_b.reshape(B_GROUPS, B_GROUP_DIM))
    vc = vg.reshape(b, nc, SGU_CHUNK, B_GROUPS, B_GROUP_DIM)
    mixed = jnp.einsum('gts,bnsgc->bntgc', w_s, vc) + jnp.swapaxes(b_s, 0, 1)[:, :, None]
    return u * mixed.reshape(b, n, B_WIDTH)


def _short_conv(x, w):
    ch = x.shape[-1]
    y = lax.conv_general_dilated(x, w.astype(x.dtype)[:, None, :], window_strides=(1,),
                                 padding=[(CONV_K // 2, CONV_K // 2)],
                                 dimension_numbers=('NWC', 'WIO', 'NWC'),
                                 feature_group_count=ch)
    return jax.nn.silu(y)


def _gdn_features(cq, ck, cv, ca, cb, conv_w, a_log, dt_bias):
    b, t = cq.shape[:2]
    qkv = _short_conv(jnp.concatenate([cq, ck, cv], axis=-1), conv_w).astype(jnp.float32)
    q, k, v = jnp.split(qkv, 3, axis=-1)
    q = _l2norm(q.reshape(b, t, C_HEADS, C_HEAD_DIM)) * (C_HEAD_DIM ** -0.5)
    k = _l2norm(k.reshape(b, t, C_HEADS, C_HEAD_DIM))
    v = v.reshape(b, t, C_HEADS, C_HEAD_DIM)
    a = ca.astype(jnp.float32).reshape(b, t, N_DIRS, C_HEADS)
    g = -jnp.exp(a_log.astype(jnp.float32)) * jax.nn.softplus(a + dt_bias.astype(jnp.float32))
    beta = jax.nn.sigmoid(cb.astype(jnp.float32).reshape(b, t, N_DIRS, C_HEADS))
    return q, k, v, g, beta


def _gdn_chunked(q, k, v, g, beta, s0):
    b, t, h, dk = q.shape
    dv = v.shape[-1]
    c = GDN_CHUNK
    n = t // c
    q = q.reshape(b, n, c, h, dk)
    k = k.reshape(b, n, c, h, dk)
    v = v.reshape(b, n, c, h, dv)
    beta = beta.reshape(b, n, c, h)
    gc = jnp.cumsum(g.reshape(b, n, c, h), axis=2)
    gch = jnp.moveaxis(gc, 3, 2)
    idx = jnp.arange(c)
    lower = idx[:, None] >= idx[None, :]
    strict = idx[:, None] > idx[None, :]
    decay = jnp.exp(jnp.where(lower, gch[..., :, None] - gch[..., None, :], NEG_INF))
    kb = k * beta[..., None]
    a_mat = jnp.where(strict, jnp.einsum('bnihd,bnjhd->bnhij', kb, k) * decay, 0.0)
    eye = jnp.eye(c, dtype=jnp.float32)
    t_mat = lax.linalg.triangular_solve(a_mat + eye, jnp.broadcast_to(eye, a_mat.shape),
                                        left_side=True, lower=True, unit_diagonal=True)
    u = jnp.einsum('bnhij,bnjhd->bnihd', t_mat, v * beta[..., None])
    w = jnp.einsum('bnhij,bnjhd->bnihd', t_mat, kb * jnp.exp(gc)[..., None])
    a_qk = jnp.einsum('bnihd,bnjhd->bnhij', q, k) * decay
    g_last = gc[:, :, -1]
    q_dec = q * jnp.exp(gc)[..., None]
    k_dec = k * jnp.exp(g_last[:, :, None, :] - gc)[..., None]

    def step(state, xs):
        qd, kd, uc, wc, aqk, gl = xs
        v_new = uc - jnp.einsum('bihk,bhkv->bihv', wc, state)
        o = jnp.einsum('bihk,bhkv->bihv', qd, state) + jnp.einsum('bhij,bjhv->bihv', aqk, v_new)
        state = state * jnp.exp(gl)[:, :, None, None] + jnp.einsum('bjhk,bjhv->bhkv', kd, v_new)
        return state, o

    xs = tuple(jnp.moveaxis(a, 1, 0) for a in (q_dec, k_dec, u, w, a_qk, g_last))
    s_fin, o = lax.scan(step, s0.astype(jnp.float32), xs)
    o = jnp.moveaxis(o, 0, 1).reshape(b, t, h, dv)
    return o, s_fin


def _gdn_bidir(q, k, v, g, beta, s0):
    flip = lambda a: jnp.flip(a, axis=1)
    o_f, s_f = _gdn_chunked(q, k, v, g[:, :, 0], beta[:, :, 0], s0[:, 0])
    o_b, s_b = _gdn_chunked(flip(q), flip(k), flip(v), flip(g[:, :, 1]), flip(beta[:, :, 1]), s0[:, 1])
    return o_f + flip(o_b), jnp.stack([s_f, s_b], axis=1)


def _gdn_output(o, norm_g, gate):
    b, t = o.shape[:2]
    o = _rmsnorm(o, norm_g).reshape(b, t, C_WIDTH).astype(gate.dtype)
    return o * jax.nn.silu(gate)


def _modulated_proj(x, cond, w_mod, b_mod, g_pre, w_in):
    mod = jax.nn.silu(cond) @ w_mod + b_mod
    shift, scale, gate = jnp.split(mod, 3, axis=-1)
    h = _rmsnorm(x, g_pre) * (1.0 + scale[:, None, :]) + shift[:, None, :]
    z = h @ w_in
    offs, acc = [], 0
    for width in IN_SPLITS[:-1]:
        acc += width
        offs.append(acc)
    return jnp.split(z, offs, axis=-1), gate


def _residual(x, outs, gate, w_out, g_post):
    mix = jnp.concatenate(outs, axis=-1) @ w_out
    return x + gate[:, None, :] * _rmsnorm(mix, g_post)


def _context_layer(x, c_ctx, prm):
    (w_mod, b_mod, g_pre, w_in, sink, ln_g, ln_b, sgu_w, sgu_b,
     conv_w, a_log, dt_bias, norm_g, g_post, w_out) = prm
    b, s = x.shape[:2]
    parts, gate = _modulated_proj(x, c_ctx[None, :], w_mod, b_mod, g_pre, w_in)
    aq, ak, av, ag, bu, bv, bg, cq, ck, cv, ca, cb, cg = parts
    q = aq.reshape(b, s, A_KV_HEADS, A_GROUP, HEAD_DIM)
    k = ak.reshape(b, s, A_KV_HEADS, HEAD_DIM)
    v = av.reshape(b, s, A_KV_HEADS, HEAD_DIM)
    o_a = _context_attention(q, k, v, sink.reshape(A_KV_HEADS, A_GROUP)) * jax.nn.silu(ag)
    o_b = _sgu(bu, bv, ln_g, ln_b, sgu_w, sgu_b) * jax.nn.silu(bg)
    q_c, k_c, v_c, g_c, beta_c = _gdn_features(cq, ck, cv, ca, cb, conv_w, a_log, dt_bias)
    s0 = jnp.zeros((b, N_DIRS, C_HEADS, C_HEAD_DIM, C_HEAD_DIM), jnp.float32)
    o_c, s_fin = _gdn_bidir(q_c, k_c, v_c, g_c, beta_c, s0)
    o_c = _gdn_output(o_c, norm_g, cg)
    return _residual(x, [o_a, o_b, o_c], gate, w_out, g_post), k, v, s_fin


def _latent_layer(x, c, prm, k_ctx, v_ctx, s_ctx):
    (w_mod, b_mod, g_pre, w_in, sink, ln_g, ln_b, sgu_w, sgu_b,
     conv_w, a_log, dt_bias, norm_g, g_post, w_out) = prm
    b, n = x.shape[:2]
    parts, gate = _modulated_proj(x, c, w_mod, b_mod, g_pre, w_in)
    aq, ak, av, ag, bu, bv, bg, cq, ck, cv, ca, cb, cg = parts
    q = _rope_2d(aq.reshape(b, n, A_HEADS, HEAD_DIM)).reshape(b, n, A_KV_HEADS, A_GROUP, HEAD_DIM)
    k = _rope_2d(ak.reshape(b, n, A_KV_HEADS, HEAD_DIM))
    v = av.reshape(b, n, A_KV_HEADS, HEAD_DIM)
    o_a = _latent_attention(q, k, v, k_ctx, v_ctx, sink.reshape(A_KV_HEADS, A_GROUP)) * jax.nn.silu(ag)
    o_b = _sgu(bu, bv, ln_g, ln_b, sgu_w, sgu_b) * jax.nn.silu(bg)
    q_c, k_c, v_c, g_c, beta_c = _gdn_features(cq, ck, cv, ca, cb, conv_w, a_log, dt_bias)
    o_c, _ = _gdn_bidir(q_c, k_c, v_c, g_c, beta_c, s_ctx)
    o_c = _gdn_output(o_c, norm_g, cg)
    return _residual(x, [o_a, o_b, o_c], gate, w_out, g_post)


def setup_inputs(seed: int = 0) -> dict:
    key = jax.random.key(seed)
    ks = jax.random.split(key, 24)
    f32 = jnp.float32

    def nrm(k, shape, s):
        return s * jax.random.normal(k, shape, f32)

    dt = jnp.exp(jax.random.uniform(ks[18], (DEPTH, N_DIRS, C_HEADS), f32,
                                    math.log(1e-3), math.log(1e-1)))
    return {
        'x_prompt': nrm(ks[0], (BATCH, SEQ, D_MODEL), 1.0),
        'x_sample': nrm(ks[1], (DEC_BATCH, DEC_SEQ, D_MODEL), 1.0),
        'cache_k': nrm(ks[2], (DEC_BATCH, DEPTH, PAST_LEN, A_KV_HEADS, HEAD_DIM), 1.0),
        'cache_v': nrm(ks[3], (DEC_BATCH, DEPTH, PAST_LEN, A_KV_HEADS, HEAD_DIM), 1.0),
        'state_delta': nrm(ks[4], (DEC_BATCH, DEPTH, N_DIRS, C_HEADS, C_HEAD_DIM, C_HEAD_DIM), 0.2),
        'c': nrm(ks[5], (DEC_BATCH, D_MODEL), 1.0),
        'c_ctx': nrm(ks[6], (D_MODEL,), 1.0),
        'w_mod': nrm(ks[7], (DEPTH, D_MODEL, 3 * D_MODEL), 0.5 * D_MODEL ** -0.5),
        'b_mod': nrm(ks[8], (DEPTH, 3 * D_MODEL), 0.01),
        'g_pre': 1.0 + nrm(ks[9], (DEPTH, D_MODEL), 0.05),
        'w_in': nrm(ks[10], (DEPTH, D_MODEL, IN_COLS), D_MODEL ** -0.5),
        'attn_sink': nrm(ks[11], (DEPTH, A_HEADS), 0.5),
        'sgu_ln_g': 1.0 + nrm(ks[12], (DEPTH, B_WIDTH), 0.05),
        'sgu_ln_b': nrm(ks[13], (DEPTH, B_WIDTH), 0.01),
        'sgu_w': nrm(ks[14], (DEPTH, B_GROUPS, SGU_CHUNK, SGU_CHUNK), 0.5 * SGU_CHUNK ** -0.5),
        'sgu_b': 1.0 + nrm(ks[15], (DEPTH, B_GROUPS, SGU_CHUNK), 0.05),
        'gdn_conv_w': nrm(ks[16], (DEPTH, CONV_K, 3 * C_WIDTH), CONV_K ** -0.5),
        'gdn_a_log': jnp.log(jax.random.uniform(ks[17], (DEPTH, N_DIRS, C_HEADS), f32, 1.0, 16.0)),
        'gdn_dt_bias': dt + jnp.log(-jnp.expm1(-dt)),
        'gdn_norm_g': 1.0 + nrm(ks[19], (DEPTH, C_HEAD_DIM), 0.05),
        'g_post': 1.0 + nrm(ks[20], (DEPTH, D_MODEL), 0.05),
        'w_out': nrm(ks[21], (DEPTH, D_MIX, D_MODEL), D_MIX ** -0.5),
    }


def reference(x_prompt, x_sample, cache_k, cache_v, state_delta, c, c_ctx,
              w_mod, b_mod, g_pre, w_in, attn_sink, sgu_ln_g, sgu_ln_b, sgu_w, sgu_b,
              gdn_conv_w, gdn_a_log, gdn_dt_bias, gdn_norm_g, g_post, w_out):
    xp = x_prompt
    xs = x_sample
    new_k, new_v, new_s = [], [], []
    for l in range(DEPTH):
        prm = (w_mod[l], b_mod[l], g_pre[l], w_in[l], attn_sink[l], sgu_ln_g[l], sgu_ln_b[l],
               sgu_w[l], sgu_b[l], gdn_conv_w[l], gdn_a_log[l], gdn_dt_bias[l], gdn_norm_g[l],
               g_post[l], w_out[l])
        xp, k_l, v_l, s_l = _context_layer(xp, c_ctx, prm)
        xs = _latent_layer(xs, c, prm, cache_k[:, l], cache_v[:, l], state_delta[:, l])
        new_k.append(k_l)
        new_v.append(v_l)
        new_s.append(s_l)
    new_cache_k = jnp.stack(new_k, axis=1)
    new_cache_v = jnp.stack(new_v, axis=1)
    new_state_delta = jnp.stack(new_s, axis=1)
    return (xp, xs, new_cache_k, new_cache_v, new_state_delta)
```

```cpp
#include <hip/hip_runtime.h>
#include <hip/hip_cooperative_groups.h>
#include <cstdio>
namespace cg = cooperative_groups;

#ifndef ONE_LAUNCH
#define ONE_LAUNCH 1
#ifndef PROBE_MASK
#define PROBE_MASK 0
#endif
#endif

typedef unsigned short u16;
using bf16x8 = __attribute__((ext_vector_type(8))) short;
using bf16x4 = __attribute__((ext_vector_type(4))) short;
using f32x4 = __attribute__((ext_vector_type(4))) float;
using f32x16 = __attribute__((ext_vector_type(16))) float;
#define DEVI __device__ __forceinline__
#define LAUNDER(p) asm volatile("" : "+v"(p))
DEVI void lds_barrier() { asm volatile("s_waitcnt lgkmcnt(0)\n\ts_barrier" ::: "memory"); }

constexpr int NCTX = 8192, ZC = 3088;
constexpr int AQ = 0, AK = 512, AV = 640, AG = 768, BU = 1280, BV = 1536, BG = 1792, CQ = 2048, CK = 2304,
              CV = 2560, CA = 2816, CB = 2824, CG = 2832;
constexpr float EPS = 1e-6f;
constexpr size_t WS_CTR = 0, WS_MOD = 4096, WS_ROPE = 225280, WS_GL = 233472, WS_PART = 253952,
                 WS_SGUW = 2875392, WS_WOUT = 3137536, WS_WIN = 7331840, WS_Z = 20439040,
                 WS_R3 = 273408000, WS_END = 483123200, MIXOFF = 83886080;
constexpr size_t OFF_CK = 41943040, OFF_CV = 44040192, OFF_ST = 46137344;
constexpr int SMEM_BYTES = 77824;
constexpr int SITEM_OFF = 77808;
constexpr int XBST_OFF = 77776;
constexpr size_t WS_BAR = 483123200;

struct P {
  const float *xp, *xs, *cache_k, *cache_v, *state, *c, *cctx, *w_mod, *b_mod, *g_pre, *w_in, *sink, *ln_g,
      *ln_b, *sgu_w, *sgu_b, *conv_w, *a_log, *dt_bias, *norm_g, *g_post, *w_out;
  float* out;
  unsigned char* ws;
};

DEVI u16 f2bf(float f) {
  __bf16 b = (__bf16)f;
  return __builtin_bit_cast(u16, b);
}
DEVI int permg(int k0) { return (k0 & 32) | ((k0 & 12) << 1) | ((k0 & 16) >> 2); }
DEVI float bf2f(u16 h) { return __uint_as_float(((unsigned)h) << 16); }
DEVI float bfs(short h) { return __uint_as_float(((unsigned)(u16)h) << 16); }
DEVI float silu(float x) { return x * __builtin_amdgcn_rcpf(1.f + __expf(-x)); }
DEVI f32x4 mfma16(bf16x8 a, bf16x8 b, f32x4 c) { return __builtin_amdgcn_mfma_f32_16x16x32_bf16(a, b, c, 0, 0, 0); }
DEVI f32x16 mfma32(bf16x8 a, bf16x8 b, f32x16 c) { return __builtin_amdgcn_mfma_f32_32x32x16_bf16(a, b, c, 0, 0, 0); }


#define XB_TMO 128
#define XB_XCNT(j) (256 + 64 * (j))
#define XB_XSUB(j) (1280 + 64 * (j))
#define XB_XGEN(j) (2304 + 64 * (j))
#define XB_TOP 3328
#define XB_TOPGEN 3392
#define XB_SPIN_CAP (1u << 18)
#define LAS __attribute__((address_space(3)))
DEVI unsigned xb_ld(unsigned* p) { return __hip_atomic_load(p, __ATOMIC_RELAXED, __HIP_MEMORY_SCOPE_AGENT); }
DEVI unsigned xb_add(unsigned* p, unsigned v) { return __hip_atomic_fetch_add(p, v, __ATOMIC_RELAXED, __HIP_MEMORY_SCOPE_AGENT); }
DEVI unsigned xb_xcc_id() { return (unsigned)__builtin_amdgcn_s_getreg((3 << 11) | 20) & 0xFu; }
#define XB_SPIN(cond, bar)                                   \
  do {                                                       \
    unsigned _sp = 0;                                        \
    while (cond) {                                           \
      __builtin_amdgcn_s_sleep(1);                           \
      if ((++_sp & 255u) == 0u) {                            \
        if (xb_ld(&(bar)[XB_TMO])) break;                    \
        if (_sp > XB_SPIN_CAP) {                             \
          atomicAdd(&(bar)[XB_TMO], 1u);                     \
          break;                                             \
        }                                                    \
      }                                                      \
    }                                                        \
  } while (0)
struct XcdBarrier {
  unsigned* bar;
  unsigned x;
  volatile LAS unsigned* st;
};
DEVI XcdBarrier xcd_barrier_post(unsigned* bar, volatile LAS unsigned* st) {
  XcdBarrier b;
  b.bar = bar;
  b.x = xb_xcc_id();
  b.st = st;
  if (threadIdx.x == 0) (void)xb_add(&bar[XB_XCNT(b.x)], 1u);
  return b;
}
DEVI void xcd_barrier_complete(unsigned* bar, unsigned x, unsigned& nloc, unsigned& nx) {
  const unsigned G = gridDim.x * gridDim.y * gridDim.z;
  unsigned sum, cnt, mine, sp = 0u;
  for (;;) {
    sum = 0u;
    cnt = 0u;
    mine = 0u;
#pragma unroll
    for (unsigned j = 0; j < 16; ++j) {
      const unsigned c = xb_ld(&bar[XB_XCNT(j)]);
      sum += c;
      cnt += (c > 0u) ? 1u : 0u;
      mine = (j == x) ? c : mine;
    }
    if (sum == G) break;
    __builtin_amdgcn_s_sleep(1);
    if ((++sp & 255u) == 0u) {
      if (xb_ld(&bar[XB_TMO])) break;
      if (sp > XB_SPIN_CAP) {
        atomicAdd(&bar[XB_TMO], 1u);
        break;
      }
    }
  }
  nloc = mine > 0u ? mine : 1u;
  nx = cnt > 0u ? cnt : 1u;
}
DEVI void xcd_barrier(const XcdBarrier& b) {
  asm volatile("s_waitcnt vmcnt(0)" ::: "memory");
  __syncthreads();
  if (threadIdx.x == 0) {
    unsigned* bar = b.bar;
    __builtin_amdgcn_s_waitcnt(0);
    unsigned nloc = b.st[0], nx = b.st[1];
    if (nloc == 0u) {
      xcd_barrier_complete(bar, b.x, nloc, nx);
      b.st[0] = nloc;
      b.st[1] = nx;
    }
    const unsigned old = xb_add(&bar[XB_XSUB(b.x)], 1u);
    const unsigned gen = old / nloc;
    if (old + 1u == (gen + 1u) * nloc) {
      __builtin_amdgcn_fence(__ATOMIC_RELEASE, "agent");
      asm volatile("s_waitcnt vmcnt(0)" ::: "memory");
      const unsigned og = xb_add(&bar[XB_TOP], 1u);
      const unsigned tg = og / nx;
      if (og + 1u == (tg + 1u) * nx)
        xb_add(&bar[XB_TOPGEN], 1u);
      else
        XB_SPIN(xb_ld(&bar[XB_TOPGEN]) == tg, bar);
      __builtin_amdgcn_fence(__ATOMIC_ACQUIRE, "agent");
      xb_add(&bar[XB_XGEN(b.x)], 1u);
      asm volatile("s_waitcnt vmcnt(0)" ::: "memory");
    } else {
      XB_SPIN(xb_ld(&bar[XB_XGEN(b.x)]) == gen, bar);
      __builtin_amdgcn_fence(__ATOMIC_ACQUIRE, "agent");
      asm volatile("s_waitcnt vmcnt(0)" ::: "memory");
    }
  }
  __syncthreads();
}

__device__ void phase0(const P& p, char* smem) {
  const int tid = threadIdx.x;
  float* mod = (float*)(p.ws + WS_MOD);
  for (int it = blockIdx.x; it < 2337; it += gridDim.x) {
    __syncthreads();
    if (it < 192) {
      int l = it / 96, c0 = (it % 96) * 32;
      float* sc = (float*)smem;
      for (int e = tid; e < 9 * 1024; e += 256) {
        int j = e >> 10, k = e & 1023;
        float v = j == 0 ? p.cctx[k] : p.c[(j - 1) * 1024 + k];
        sc[e] = silu(v);
      }
      __syncthreads();
      int col = tid & 31, kp = tid >> 5;
      float acc[9];
#pragma unroll
      for (int j = 0; j < 9; ++j) acc[j] = 0.f;
      const float* w = p.w_mod + (size_t)l * 1024 * 3072 + c0 + col;
#pragma unroll 8
      for (int k = kp * 128; k < kp * 128 + 128; ++k) {
        float wv = w[(size_t)k * 3072];
#pragma unroll
        for (int j = 0; j < 9; ++j) acc[j] += sc[j * 1024 + k] * wv;
      }
      float* red = (float*)(smem + 36864);
#pragma unroll
      for (int j = 0; j < 9; ++j) red[(kp * 9 + j) * 32 + col] = acc[j];
      __syncthreads();
      for (int e = tid; e < 288; e += 256) {
        int j = e / 32, cc = e % 32;
        float s = p.b_mod[l * 3072 + c0 + cc];
        for (int k2 = 0; k2 < 8; ++k2) s += red[(k2 * 9 + j) * 32 + cc];
        mod[(l * 9 + j) * 3072 + c0 + cc] = s;
      }
    } else if (it < 192 + 1600 + 512) {
      int r = it - 192;
      const float* src;
      u16* dst;
      int ncols, nvalid, n0, k0;
      if (r < 1600) {
        int l = r / 800;
        r %= 800;
        n0 = (r / 16) * 64;
        k0 = (r % 16) * 64;
        src = p.w_in + (size_t)l * 1024 * 3088;
        dst = (u16*)(p.ws + WS_WIN) + (size_t)l * 3200 * 1024;
        ncols = 3088;
        nvalid = 3088;
      } else {
        r -= 1600;
        int l = r / 256;
        r %= 256;
        n0 = (r / 16) * 64;
        k0 = (r % 16) * 64;
        src = p.w_out + (size_t)l * 1024 * 1024;
        dst = (u16*)(p.ws + WS_WOUT) + (size_t)l * 1024 * 1024;
        ncols = 1024;
        nvalid = 1024;
      }
      float* tile = (float*)smem;
      int nn = tid & 63;
      for (int i = 0; i < 16; ++i) {
        int kk = (tid >> 6) + 4 * i;
        float v = 0.f;
        if (n0 + nn < nvalid) v = src[(size_t)(k0 + kk) * ncols + n0 + nn];
        tile[kk * 65 + nn] = v;
      }
      __syncthreads();
      int kk2 = tid & 63;
      for (int i = 0; i < 16; ++i) {
        int nn2 = (tid >> 6) + 4 * i;
        dst[(size_t)(n0 + nn2) * 1024 + k0 + kk2] = f2bf(tile[kk2 * 65 + nn2]);
      }
    } else if (it < 192 + 1600 + 512 + 32) {
      int r = it - (192 + 1600 + 512);
      u16* d = (u16*)(p.ws + WS_SGUW);
      for (int i = 0; i < 16; ++i) {
        int e = r * 4096 + i * 256 + tid;
        d[e] = f2bf(p.sgu_w[e]);
      }
    } else {
      float* rc = (float*)(p.ws + WS_ROPE);
      for (int i = 0; i < 4; ++i) {
        int e = i * 256 + tid;
        int pos = e >> 4, f = e & 15;
        float inv = powf(10000.f, -(float)f / 16.f);
        float ang = (float)pos * inv;
        rc[e] = cosf(ang);
        rc[1024 + e] = sinf(ang);
      }
    }
  }
}

__device__ void row_phase(const P& p, int mode) {
  int tid = threadIdx.x;
  asm volatile("" : "+v"(tid));
  const int lane = tid & 63, wv = tid >> 6;
  const float* mod = (const float*)(p.ws + WS_MOD);
  for (int it = blockIdx.x; it < 5120; it += gridDim.x) {
    const int rowb = it * 8 + wv * 2;
    float4 x[2][4];
    bf16x4 mv[2][4];
    float ssp[2];
#pragma unroll
    for (int rr = 0; rr < 2; ++rr) {
      const int row = rowb + rr;
      const float* xin = row < NCTX ? p.xp + (size_t)row * 1024 : p.xs + (size_t)(row - NCTX) * 1024;
      const float* yout = p.out + (size_t)row * 1024;
#pragma unroll
      for (int i = 0; i < 4; ++i)
      {
        typedef float f4v __attribute__((ext_vector_type(4)));
        const f4v* sp_ = (mode == 2) ? (const f4v*)yout : (const f4v*)xin;
        f4v t_ = __builtin_nontemporal_load(sp_ + i * 64 + lane);
        x[rr][i] = make_float4(t_[0], t_[1], t_[2], t_[3]);
      }
      if (mode >= 1) {
        const u16* mix = (const u16*)(p.ws + WS_R3 + MIXOFF) + (size_t)row * 1024;
#pragma unroll
        for (int i = 0; i < 4; ++i) mv[rr][i] = __builtin_nontemporal_load((const bf16x4*)(mix + (i * 64 + lane) * 4));
        const float* part = (const float*)(p.ws + WS_PART) + (size_t)row * 16;
        float4 p0 = ((const float4*)part)[0], p1 = ((const float4*)part)[1], p2 = ((const float4*)part)[2],
               p3 = ((const float4*)part)[3];
        ssp[rr] = ((p0.x + p0.y) + (p0.z + p0.w)) + ((p1.x + p1.y) + (p1.z + p1.w)) + ((p2.x + p2.y) + (p2.z + p2.w)) +
                  ((p3.x + p3.y) + (p3.z + p3.w));
      }
    }
#pragma unroll
    for (int rr = 0; rr < 2; ++rr) {
      const int row = rowb + rr;
      const int cond = row < NCTX ? 0 : 1 + ((row - NCTX) >> 12);
      float* yout = p.out + (size_t)row * 1024;
      if (mode >= 1) {
        const int l = mode - 1;
        const float rstd = rsqrtf(ssp[rr] * (1.f / 1024.f) + EPS);
        const float* gate = mod + (size_t)(l * 9 + cond) * 3072 + 2048;
        const float* gp = p.g_post + l * 1024;
#pragma unroll
        for (int i = 0; i < 4; ++i) {
          int c = (i * 64 + lane) * 4;
          float4 g4 = *(const float4*)(gate + c);
          float4 p4 = *(const float4*)(gp + c);
          x[rr][i].x += g4.x * bfs(mv[rr][i][0]) * rstd * p4.x;
          x[rr][i].y += g4.y * bfs(mv[rr][i][1]) * rstd * p4.y;
          x[rr][i].z += g4.z * bfs(mv[rr][i][2]) * rstd * p4.z;
          x[rr][i].w += g4.w * bfs(mv[rr][i][3]) * rstd * p4.w;
          {
            typedef float f4v __attribute__((ext_vector_type(4)));
            f4v t_ = {x[rr][i].x, x[rr][i].y, x[rr][i].z, x[rr][i].w};
            __builtin_nontemporal_store(t_, (f4v*)yout + i * 64 + lane);
          }
        }
      }
      if (mode <= 1) {
        const int l = mode;
        float ss = 0.f;
#pragma unroll
        for (int i = 0; i < 4; ++i)
          ss += x[rr][i].x * x[rr][i].x + x[rr][i].y * x[rr][i].y + x[rr][i].z * x[rr][i].z + x[rr][i].w * x[rr][i].w;
#pragma unroll
        for (int o = 1; o < 64; o <<= 1) ss += __shfl_xor(ss, o);
        const float rstd = rsqrtf(ss * (1.f / 1024.f) + EPS);
        const float* md = mod + (size_t)(l * 9 + cond) * 3072;
        const float* gpre = p.g_pre + l * 1024;
        u16* h = (u16*)(p.ws + WS_R3) + (size_t)row * 1024;
#pragma unroll
        for (int i = 0; i < 4; ++i) {
          int c = (i * 64 + lane) * 4;
          float4 g4 = *(const float4*)(gpre + c);
          float4 sh = *(const float4*)(md + c);
          float4 sc = *(const float4*)(md + 1024 + c);
          bf16x4 o;
          o[0] = (short)f2bf(x[rr][i].x * rstd * g4.x * (1.f + sc.x) + sh.x);
          o[1] = (short)f2bf(x[rr][i].y * rstd * g4.y * (1.f + sc.y) + sh.y);
          o[2] = (short)f2bf(x[rr][i].z * rstd * g4.z * (1.f + sc.z) + sh.z);
          o[3] = (short)f2bf(x[rr][i].w * rstd * g4.w * (1.f + sc.w) + sh.w);
          *(bf16x4*)(h + c) = o;
        }
      }
    }
  }
}

template <int MODE>
__device__ void gemm_phase(const P& p, int l, char* smem) {
  int tid = threadIdx.x;
  asm volatile("" : "+v"(tid));
  const int lane = tid & 63, wv = tid >> 6, wr = wv >> 1, wc = wv & 1, fr = lane & 15,
            fq = lane >> 4;
  u16* As = (u16*)smem;
  u16* Bs = (u16*)(smem + 18432);
  const u16* A = MODE == 0 ? (const u16*)(p.ws + WS_R3) : (const u16*)(p.ws + WS_Z);
  const int lda = MODE == 0 ? 1024 : ZC;
  const u16* Bt = MODE == 0 ? (const u16*)(p.ws + WS_WIN) + (size_t)l * 3200 * 1024
                            : (const u16*)(p.ws + WS_WOUT) + (size_t)l * 1024 * 1024;
  const int NT = MODE == 0 ? 25 : 8;
  const int ntiles = 320 * NT;
  const int lrow = tid >> 3, lseg = tid & 7;
  u16* z = (u16*)(p.ws + WS_Z);
  const int NG8 = NT / 8, ngmain = 40 * NG8, ngroups = ngmain + ((NT % 8) ? 5 : 0);
  (void)ntiles;
  int aoff[4], boff[4];
#pragma unroll
  for (int i = 0; i < 4; ++i) {
    const int bb = tid * 16 + i * 4096;
    const int st = bb >> 10, sb = bb & 1023, swz = sb ^ (((sb >> 9) & 1) << 5);
    const int R = (st >> 1) * 16 + (swz >> 6), C = (st & 1) * 32 + ((swz & 63) >> 1);
    aoff[i] = R * lda + C;
    boff[i] = R * 1024 + C;
  }
  const int flo = (fr * 64 + fq * 16) ^ ((fr >> 3) << 5);
  int* gctr = (int*)(p.ws + WS_CTR) + 256 + ((l * 2 + MODE) * 8) * 16;
  int* sitem = (int*)(smem + SITEM_OFF);
  const int x0 = (int)(xb_xcc_id() & 7u);
  for (int dx = 0; dx < 8; ++dx)
  for (;;) {
    const int xq = (x0 + dx) & 7;
    __syncthreads();
    if (threadIdx.x == 0) *sitem = atomicAdd(gctr + xq * 16, 1);
    __syncthreads();
    const int sq = __builtin_amdgcn_readfirstlane(*sitem);
    const int g = xq + 8 * (sq >> 6), idx = sq & 63;
    if (g >= ngroups) break;
    int mt, nt;
    if (g < ngmain) {
      mt = (g / NG8) * 8 + (idx & 7);
      nt = (g % NG8) * 8 + (idx >> 3);
    } else {
      mt = (g - ngmain) * 64 + idx;
      nt = NT - 1;
    }
    int m0 = mt * 128, n0 = nt * 128;
    f32x4 acc[4][4];
#pragma unroll
    for (int i = 0; i < 4; ++i)
#pragma unroll
      for (int j = 0; j < 4; ++j) acc[i][j] = f32x4{0.f, 0.f, 0.f, 0.f};
#define GDMA(kt, stg)                                                                              \
  {                                                                                                \
    int k0_ = (kt) * 64;                                                                           \
    int ka_ = MODE == 0 ? k0_ : (k0_ < 512 ? k0_ : (k0_ < 768 ? BU + k0_ - 512 : CQ + k0_ - 768)); \
    const u16* Ab_ = A + (size_t)m0 * lda + ka_;                                                   \
    const u16* Bb_ = Bt + (size_t)n0 * 1024 + k0_;                                                 \
    char* sd_ = smem + (stg) * 32768 + tid * 16;                                                   \
    _Pragma("unroll") for (int i = 0; i < 4; ++i) {                                                \
      __builtin_amdgcn_global_load_lds((const unsigned*)(Ab_ + aoff[i]), (unsigned*)(sd_ + i * 4096), 16, 0, 0); \
      __builtin_amdgcn_global_load_lds((const unsigned*)(Bb_ + boff[i]), (unsigned*)(sd_ + 16384 + i * 4096), 16, 0, 0); \
    }                                                                                              \
  }
    lds_barrier();
    GDMA(0, 0);
    for (int kt = 0; kt < 16; ++kt) {
      asm volatile("s_waitcnt vmcnt(0)" ::: "memory");
      lds_barrier();
      if (kt + 1 < 16) GDMA(kt + 1, (kt + 1) & 1);
      const char* stA = smem + (kt & 1) * 32768 + flo;
      const char* stB = stA + 16384;
#pragma unroll
      for (int ks = 0; ks < 2; ++ks) {
        bf16x8 a[4], b[4];
#pragma unroll
        for (int i = 0; i < 4; ++i) {
          a[i] = *(const bf16x8*)(stA + ((wr * 4 + i) * 2 + ks) * 1024);
          b[i] = *(const bf16x8*)(stB + ((wc * 4 + i) * 2 + ks) * 1024);
        }
#pragma unroll
        for (int mi = 0; mi < 4; ++mi)
#pragma unroll
          for (int ni = 0; ni < 4; ++ni) acc[mi][ni] = mfma16(b[ni], a[mi], acc[mi][ni]);
      }
    }
#undef GDMA
    if (MODE == 0) {
      const bool latent = m0 >= NCTX;
      const bool dorope = latent && nt < 5;
      const float* ropec = (const float*)(p.ws + WS_ROPE);
      const float* ropes = ropec + 1024;
#pragma unroll
      for (int mi = 0; mi < 4; ++mi) {
        const int row = m0 + wr * 64 + mi * 16 + fr;
        f32x4 v0 = acc[mi][0], v1 = acc[mi][1], v2 = acc[mi][2], v3 = acc[mi][3];
        if (dorope) {
          const int pos = (row - NCTX) & 4095;
          const int pr = pos >> 6, pc = pos & 63;
          const float4 c0 = *(const float4*)(ropec + pr * 16 + fq * 4), s0 = *(const float4*)(ropes + pr * 16 + fq * 4);
          const float4 c1 = *(const float4*)(ropec + pc * 16 + fq * 4), s1 = *(const float4*)(ropes + pc * 16 + fq * 4);
          const float cc0[4] = {c0.x, c0.y, c0.z, c0.w}, ss0[4] = {s0.x, s0.y, s0.z, s0.w};
          const float cc1[4] = {c1.x, c1.y, c1.z, c1.w}, ss1[4] = {s1.x, s1.y, s1.z, s1.w};
#pragma unroll
          for (int r = 0; r < 4; ++r) {
            float t0 = v0[r] * cc0[r] - v1[r] * ss0[r], t1 = v1[r] * cc0[r] + v0[r] * ss0[r];
            v0[r] = t0;
            v1[r] = t1;
            float t2 = v2[r] * cc1[r] - v3[r] * ss1[r], t3 = v3[r] * cc1[r] + v2[r] * ss1[r];
            v2[r] = t2;
            v3[r] = t3;
          }
        }
        const int cb = n0 + wc * 64 + fq * 4;
        u16* zr = z + (size_t)row * ZC;
        const f32x4 vv[4] = {v0, v1, v2, v3};
#pragma unroll
        for (int ni = 0; ni < 4; ++ni) {
          if (cb + ni * 16 < ZC) {
            bf16x4 o;
#pragma unroll
            for (int r = 0; r < 4; ++r) o[r] = (short)f2bf(vv[ni][r]);
            *(bf16x4*)(zr + cb + ni * 16) = o;
          }
        }
        if (!latent && (nt == 4 || nt == 5)) {
          float* dst = p.out + (nt == 4 ? OFF_CK : OFF_CV) + ((size_t)((row >> 8) * 2 + l) * 256 + (row & 255)) * 128 +
                       (wc * 64 + fq * 4);
#pragma unroll
          for (int ni = 0; ni < 4; ++ni)
            *(float4*)(dst + ni * 16) = make_float4(vv[ni][0], vv[ni][1], vv[ni][2], vv[ni][3]);
        }
      }
    } else {
      u16* mix = (u16*)(p.ws + WS_R3 + MIXOFF);
      float* part = (float*)(p.ws + WS_PART);
#pragma unroll
      for (int mi = 0; mi < 4; ++mi) {
        const int row = m0 + wr * 64 + mi * 16 + fr;
        float ss = 0.f;
#pragma unroll
        for (int ni = 0; ni < 4; ++ni) {
          bf16x4 o;
#pragma unroll
          for (int r = 0; r < 4; ++r) {
            float v = acc[mi][ni][r];
            ss += v * v;
            o[r] = (short)f2bf(v);
          }
          *(bf16x4*)(mix + (size_t)row * 1024 + n0 + wc * 64 + ni * 16 + fq * 4) = o;
        }
        ss += __shfl_xor(ss, 16);
        ss += __shfl_xor(ss, 32);
        if (fq == 0) part[(size_t)row * 16 + nt * 2 + wc] = ss;
      }
    }
  }
}

__device__ void attn_item(const P& p, int l, int it, char* smem, int reps) {
  int tid = threadIdx.x;
  asm volatile("" : "+v"(tid));
  const int lane = tid & 63, w = tid >> 6, ql = lane & 31, hh = lane >> 5;
  u16* Ks = (u16*)smem;
  u16* Vt = (u16*)(smem + 9216);
  u16* z = (u16*)(p.ws + WS_Z);
  int b, qb, head, tb, latent;
  if (it < 2048) {
    latent = 1;
    b = it >> 8;
    qb = (it >> 3) & 31;
    head = it & 7;
    tb = NCTX + b * 4096;
  } else {
    int j = it - 2048;
    latent = 0;
    b = j >> 4;
    qb = (j >> 3) & 1;
    head = j & 7;
    tb = b * 256;
  }
  const int kvh = head >> 2;
  const int qpos = qb * 128 + w * 32 + ql;
  const size_t qrow = (size_t)(tb + qpos);
  bf16x8 qf[4];
#pragma unroll
  for (int ks = 0; ks < 4; ++ks) qf[ks] = *(const bf16x8*)(z + qrow * ZC + AQ + head * 64 + ks * 16 + hh * 8);
  float m, lsum;
  f32x16 oacc[2];
  for (int rep_ = 0; rep_ < reps; ++rep_) {
  m = p.sink[l * 8 + head] * 1.4426950408889634f;
  lsum = hh == 0 ? 1.f : 0.f;
#pragma unroll
  for (int d = 0; d < 2; ++d)
#pragma unroll
    for (int r = 0; r < 16; ++r) oacc[d][r] = 0.f;
  int kt0, kt1;
  if (latent) {
    kt0 = max(0, qb * 2 - 2);
    kt1 = min(63, qb * 2 + 3);
  } else {
    kt0 = 0;
    kt1 = 3;
  }
  const int nwin = kt1 - kt0 + 1;
  const int ntl = nwin + (latent ? 4 : 0);
  const int skey = tid >> 2, sseg = tid & 3;
  bf16x8 wk0, wk1, wv0, wv1;
  float4 ckr[4], cvr[4];
#define AT_ISSUE(tt)                                                                              \
  {                                                                                               \
    if ((tt) < nwin) {                                                                            \
      const u16* src_ = z + (size_t)(tb + (kt0 + (tt)) * 64 + skey) * ZC + kvh * 64 + sseg * 16;  \
      wk0 = *(const bf16x8*)(src_ + AK);                                                          \
      wk1 = *(const bf16x8*)(src_ + AK + 8);                                                      \
      wv0 = *(const bf16x8*)(src_ + AV);                                                          \
      wv1 = *(const bf16x8*)(src_ + AV + 8);                                                      \
    } else if ((tt) < ntl) {                                                                      \
      int pk_ = ((tt) - nwin) * 64 + skey;                                                        \
      const float4* ck_ = (const float4*)(p.cache_k + ((size_t)(b * 2 + l) * 256 + pk_) * 128 + kvh * 64 + sseg * 16); \
      const float4* cv_ = (const float4*)(p.cache_v + ((size_t)(b * 2 + l) * 256 + pk_) * 128 + kvh * 64 + sseg * 16); \
      _Pragma("unroll") for (int i = 0; i < 4; ++i) {                                             \
        ckr[i] = ck_[i];                                                                          \
        cvr[i] = cv_[i];                                                                          \
      }                                                                                           \
    }                                                                                             \
  }
  AT_ISSUE(0);
  for (int ti = 0; ti < ntl; ++ti) {
    lds_barrier();
    const bool win = ti < nwin;
    if (win) {
      *(bf16x8*)(Ks + skey * 72 + sseg * 16) = wk0;
      *(bf16x8*)(Ks + skey * 72 + sseg * 16 + 8) = wk1;
      *(bf16x8*)(Vt + skey * 72 + sseg * 16) = wv0;
      *(bf16x8*)(Vt + skey * 72 + sseg * 16 + 8) = wv1;
    } else {
#pragma unroll
      for (int i = 0; i < 4; ++i) {
        float4 f = ckr[i];
        bf16x4 o;
        o[0] = (short)f2bf(f.x);
        o[1] = (short)f2bf(f.y);
        o[2] = (short)f2bf(f.z);
        o[3] = (short)f2bf(f.w);
        *(bf16x4*)(Ks + skey * 72 + sseg * 16 + i * 4) = o;
        float4 g = cvr[i];
        bf16x4 ov;
        ov[0] = (short)f2bf(g.x);
        ov[1] = (short)f2bf(g.y);
        ov[2] = (short)f2bf(g.z);
        ov[3] = (short)f2bf(g.w);
        *(bf16x4*)(Vt + skey * 72 + sseg * 16 + i * 4) = ov;
      }
    }
    lds_barrier();
    AT_ISSUE(ti + 1);
    int mstate = 0;
    if (win && latent) {
      const int kbase = (kt0 + ti) * 64;
      const int qlo = qb * 128 + w * 32, qhi = qlo + 31;
      if (kbase > qhi + 128 || kbase + 63 < qlo - 128)
        mstate = 2;
      else if (!(kbase >= qhi - 128 && kbase + 63 <= qlo + 128))
        mstate = 1;
    }
    if (mstate != 2) {
      f32x16 s[2];
#pragma unroll
      for (int mt = 0; mt < 2; ++mt) {
#pragma unroll
        for (int r = 0; r < 16; ++r) s[mt][r] = 0.f;
#pragma unroll
        for (int ks = 0; ks < 4; ++ks) {
          bf16x8 a = *(const bf16x8*)(Ks + (mt * 32 + ql) * 72 + ks * 16 + hh * 8);
          s[mt] = mfma32(a, qf[ks], s[mt]);
        }
      }
      const float SC = 0.125f * 1.4426950408889634f;
      float mx = -1e30f;
      if (mstate == 1) {
        const int kb0 = (kt0 + ti) * 64 + 4 * hh - qpos;
#pragma unroll
        for (int mt = 0; mt < 2; ++mt)
#pragma unroll
          for (int r = 0; r < 16; ++r) {
            int d = kb0 + mt * 32 + 8 * (r >> 2) + (r & 3);
            float v = s[mt][r] * SC;
            v = ((unsigned)(d + 128) > 256u) ? -1e30f : v;
            s[mt][r] = v;
            mx = fmaxf(mx, v);
          }
      } else {
#pragma unroll
        for (int mt = 0; mt < 2; ++mt)
#pragma unroll
          for (int r = 0; r < 16; ++r) {
            float v = s[mt][r] * SC;
            s[mt][r] = v;
            mx = fmaxf(mx, v);
          }
      }
      mx = fmaxf(mx, __shfl_xor(mx, 32));
      const float mn = fmaxf(m, mx);
      if (__any(mn > m)) {
        const float alpha = __builtin_amdgcn_exp2f(m - mn);
        lsum *= alpha;
#pragma unroll
        for (int d = 0; d < 2; ++d)
#pragma unroll
          for (int r = 0; r < 16; ++r) oacc[d][r] *= alpha;
      }
      m = mn;
      float ps = 0.f;
#pragma unroll
      for (int mt = 0; mt < 2; ++mt)
#pragma unroll
        for (int r = 0; r < 16; ++r) {
          float pv = __builtin_amdgcn_exp2f(s[mt][r] - mn);
          s[mt][r] = pv;
          ps += pv;
        }
      lsum += ps;
#pragma unroll
      for (int mt = 0; mt < 2; ++mt)
#pragma unroll
        for (int s2 = 0; s2 < 2; ++s2) {
          bf16x8 pb;
#pragma unroll
          for (int e = 0; e < 8; ++e) pb[e] = (short)f2bf(s[mt][8 * s2 + e]);
#pragma unroll
          for (int dt = 0; dt < 2; ++dt) {
            const u16* vp = Vt + (mt * 32 + s2 * 16 + 4 * hh + ((lane & 15) >> 2)) * 72 + dt * 32 + ((lane >> 4) & 1) * 16 +
                            (lane & 3) * 4;
            typedef __attribute__((address_space(3))) bf16x4 lds_b4;
            bf16x4 a0 = __builtin_amdgcn_ds_read_tr16_b64_v4i16((lds_b4*)vp);
            bf16x4 a1 = __builtin_amdgcn_ds_read_tr16_b64_v4i16((lds_b4*)(vp + 8 * 72));
            bf16x8 a = {a0[0], a0[1], a0[2], a0[3], a1[0], a1[1], a1[2], a1[3]};
            oacc[dt] = mfma32(a, pb, oacc[dt]);
          }
        }
    }
  }
  }
  float lt = lsum + __shfl_xor(lsum, 32);
  float inv = 1.f / lt;
#pragma unroll
  for (int dt = 0; dt < 2; ++dt)
#pragma unroll
    for (int r4 = 0; r4 < 4; ++r4) {
      int d0 = dt * 32 + 8 * r4 + 4 * hh;
      bf16x4 gg = *(const bf16x4*)(z + qrow * ZC + AG + head * 64 + d0);
      bf16x4 o;
#pragma unroll
      for (int k = 0; k < 4; ++k) o[k] = (short)f2bf(oacc[dt][r4 * 4 + k] * inv * silu(bfs(gg[k])));
      *(bf16x4*)(z + qrow * ZC + AQ + head * 64 + d0) = o;
    }
}

__device__ void sgu_item(const P& p, int l, int it, char* smem) {
  int tid = threadIdx.x;
  asm volatile("" : "+v"(tid));
  const int lane = tid & 63, w = tid >> 6, fr = lane & 15, fq = lane >> 4;
  const int ch = it >> 2, g = it & 3;
  const int t0 = ch * 128;
  u16* vgT = (u16*)smem;
  u16* z = (u16*)(p.ws + WS_Z);
  {
    int s = tid >> 1, half = tid & 1;
    const u16* vp = z + (size_t)(t0 + s) * ZC + BV + g * 64 + half * 32;
    float v[32];
#pragma unroll
    for (int i = 0; i < 4; ++i) {
      bf16x8 x = *(const bf16x8*)(vp + i * 8);
#pragma unroll
      for (int e = 0; e < 8; ++e) v[i * 8 + e] = bfs(x[e]);
    }
    float sm = 0.f;
#pragma unroll
    for (int i = 0; i < 32; ++i) sm += v[i];
    sm += __shfl_xor(sm, 1);
    float mean = sm * (1.f / 64.f);
    float vs = 0.f;
#pragma unroll
    for (int i = 0; i < 32; ++i) {
      float d = v[i] - mean;
      vs += d * d;
    }
    vs += __shfl_xor(vs, 1);
    float rstd = rsqrtf(vs * (1.f / 64.f) + EPS);
    const float* lg = p.ln_g + l * 256 + g * 64 + half * 32;
    const float* lb = p.ln_b + l * 256 + g * 64 + half * 32;
#pragma unroll
    for (int i = 0; i < 32; ++i) {
      float y = (v[i] - mean) * rstd * lg[i] + lb[i];
      vgT[(half * 32 + i) * 136 + s] = f2bf(y);
    }
  }
  lds_barrier();
  const u16* W = (const u16*)(p.ws + WS_SGUW) + (size_t)(l * 4 + g) * 128 * 128;
  f32x4 acc[4][2];
#pragma unroll
  for (int i = 0; i < 4; ++i)
#pragma unroll
    for (int j = 0; j < 2; ++j) acc[i][j] = f32x4{0.f, 0.f, 0.f, 0.f};
#pragma unroll
  for (int ks = 0; ks < 4; ++ks) {
    bf16x8 a[4];
#pragma unroll
    for (int mi = 0; mi < 4; ++mi) a[mi] = *(const bf16x8*)(vgT + (mi * 16 + fr) * 136 + ks * 32 + fq * 8);
#pragma unroll
    for (int nj = 0; nj < 2; ++nj) {
      int t = (w * 2 + nj) * 16 + fr;
      bf16x8 bb = *(const bf16x8*)(W + t * 128 + ks * 32 + fq * 8);
#pragma unroll
      for (int mi = 0; mi < 4; ++mi) acc[mi][nj] = mfma16(a[mi], bb, acc[mi][nj]);
    }
  }
#pragma unroll
  for (int nj = 0; nj < 2; ++nj) {
    int t = (w * 2 + nj) * 16 + fr;
    float bs = p.sgu_b[(l * 4 + g) * 128 + t];
    u16* zr = z + (size_t)(t0 + t) * ZC;
#pragma unroll
    for (int mi = 0; mi < 4; ++mi) {
      int c0 = g * 64 + mi * 16 + fq * 4;
      bf16x4 uu = *(const bf16x4*)(zr + BU + c0), gg = *(const bf16x4*)(zr + BG + c0);
      bf16x4 o;
#pragma unroll
      for (int r = 0; r < 4; ++r) o[r] = (short)f2bf(bfs(uu[r]) * (acc[mi][nj][r] + bs) * silu(bfs(gg[r])));
      *(bf16x4*)(zr + BU + c0) = o;
    }
  }
}

__device__ void gdnpre_item(const P& p, int l, int it, char* smem) {
  int tid = threadIdx.x;
  asm volatile("" : "+v"(tid));
  const int lane = tid & 63, w = tid >> 6, fr = lane & 15, fq = lane >> 4;
  const int cgi = it >> 2, h = it & 3;
  const int tok0 = cgi * 64;
  int T, pos0;
  if (tok0 < NCTX) {
    T = 256;
    pos0 = tok0 & 255;
  } else {
    T = 4096;
    pos0 = (tok0 - NCTX) & 4095;
  }
  u16* z = (u16*)(p.ws + WS_Z);
  u16* raw = (u16*)smem;
  float* Amat = (float*)smem;
  u16* kn_s = (u16*)(smem + 33280);
  u16* qn_s = kn_s + 4608;
  u16* vT_s = (u16*)(smem + 51712);
  u16* knT_s = vT_s + 4608;
  float* gt = (float*)(smem + 70144);
  float* bt = gt + 128;
  float* glv = bt + 128;
  float* glbuf = (float*)(p.ws + WS_GL);
  float* cw_s = (float*)(smem + 71200);
  {
    bf16x8 rv[7];
    float cwv[4];
    u16 ga = 0, gb = 0;
#pragma unroll
    for (int i = 0; i < 7; ++i) {
      int e = tid + 256 * i;
      int r = e / 24, sg = e % 24;
      int pp = pos0 - 2 + r;
      rv[i] = bf16x8{0, 0, 0, 0, 0, 0, 0, 0};
      if (e < 68 * 24 && pp >= 0 && pp < T) {
        int m = sg >> 3, o = (sg & 7) * 8;
        rv[i] = *(const bf16x8*)(z + (size_t)(tok0 - 2 + r) * ZC + CQ + m * 256 + h * 64 + o);
      }
    }
#pragma unroll
    for (int i = 0; i < 4; ++i) {
      int e = tid + 256 * i;
      int tap = e / 192, ch = e % 192;
      cwv[i] = 0.f;
      if (e < 960) cwv[i] = p.conv_w[(size_t)(l * 5 + tap) * 768 + (ch >> 6) * 256 + h * 64 + (ch & 63)];
    }
    if (tid < 128) {
      const u16* zr = z + (size_t)(tok0 + (tid & 63)) * ZC;
      ga = zr[CA + (tid >> 6) * 4 + h];
      gb = zr[CB + (tid >> 6) * 4 + h];
    }
#pragma unroll
    for (int i = 0; i < 7; ++i) {
      int e = tid + 256 * i;
      if (e < 68 * 24) *(bf16x8*)(raw + (e / 24) * 192 + (e % 24) * 8) = rv[i];
    }
#pragma unroll
    for (int i = 0; i < 4; ++i) {
      int e = tid + 256 * i;
      if (e < 960) cw_s[e] = cwv[i];
    }
    if (tid < 128) {
      int dir = tid >> 6, t = tid & 63;
      float a = bf2f(ga);
      float bl = bf2f(gb);
      float xx = a + p.dt_bias[(l * 2 + dir) * 4 + h];
      float sp = xx > 20.f ? xx : log1pf(expf(xx));
      gt[dir * 64 + t] = -expf(p.a_log[(l * 2 + dir) * 4 + h]) * sp;
      bt[dir * 64 + t] = 1.f / (1.f + expf(-bl));
    }
  }
  lds_barrier();
  const int t = tid >> 2, q4 = tid & 3;
  float qv[16], kv[16], vv[16];
  {
#pragma unroll
    for (int i = 0; i < 16; ++i) {
      qv[i] = 0.f;
      kv[i] = 0.f;
      vv[i] = 0.f;
    }
#pragma unroll 1
    for (int tap = 0; tap < 5; ++tap) {
      const u16* rr = raw + (t + tap) * 192 + q4 * 16;
      const float* cwt = cw_s + tap * 192 + q4 * 16;
#pragma unroll
      for (int i = 0; i < 16; ++i) {
        qv[i] += cwt[i] * bf2f(rr[i]);
        kv[i] += cwt[64 + i] * bf2f(rr[64 + i]);
        vv[i] += cwt[128 + i] * bf2f(rr[128 + i]);
      }
    }
#pragma unroll
    for (int i = 0; i < 16; ++i) {
      qv[i] = silu(qv[i]);
      kv[i] = silu(kv[i]);
      vv[i] = silu(vv[i]);
    }
    float sq = 0.f, sk = 0.f;
#pragma unroll
    for (int i = 0; i < 16; ++i) {
      sq += qv[i] * qv[i];
      sk += kv[i] * kv[i];
    }
    sq += __shfl_xor(sq, 1);
    sq += __shfl_xor(sq, 2);
    sk += __shfl_xor(sk, 1);
    sk += __shfl_xor(sk, 2);
    float rq = rsqrtf(sq + EPS) * 0.125f, rk = rsqrtf(sk + EPS);
#pragma unroll
    for (int i = 0; i < 16; ++i) {
      qv[i] *= rq;
      kv[i] *= rk;
    }
  }
  if (w < 2) {
    const int tt = w ? 63 - lane : lane;
    float v = gt[w * 64 + tt];
#pragma unroll
    for (int o = 1; o < 64; o <<= 1) {
      float u = __shfl_up(v, o);
      if (lane >= o) v += u;
    }
    gt[w * 64 + tt] = v;
    if (lane == 63) glv[w] = v;
  }
  lds_barrier();
  unsigned boff = (unsigned)it * 40960u;
  LAUNDER(boff);
  u16* base = (u16*)(p.ws + WS_R3) + boff;
  {
    float gc0 = gt[t], gc1 = gt[64 + t], gl0 = glv[0], gl1 = glv[1];
    float e0 = __expf(gc0), e1 = __expf(gc1), f0 = __expf(gl0 - gc0), f1 = __expf(gl1 - gc1);
    u16* q0 = base + 1 * 4096 + t * 64;
    u16* q1 = base + 5 * 4096 + 1 * 4096 + (63 - t) * 64;
    u16* kd0 = base + 3 * 4096 + q4 * 1024 + permg(t & 60) + (t & 3);
    u16* kd1 = base + 5 * 4096 + 3 * 4096 + q4 * 1024 + permg((63 - t) & 60) + ((63 - t) & 3);
    const int qg0 = permg(q4 * 16), qg1 = permg(q4 * 16 + 4), qg2 = permg(q4 * 16 + 8), qg3 = permg(q4 * 16 + 12);
    bf16x8 kpk[2], qpk[2], vpk[2];
#pragma unroll
    for (int i = 0; i < 16; ++i) {
      int d = q4 * 16 + i;
      u16 kb = f2bf(kv[i]);
      kpk[i >> 3][i & 7] = (short)kb;
      qpk[i >> 3][i & 7] = (short)f2bf(qv[i]);
      vpk[i >> 3][i & 7] = (short)f2bf(vv[i]);
      (void)d;
      const int qc = ((i >> 2) == 0 ? qg0 : (i >> 2) == 1 ? qg1 : (i >> 2) == 2 ? qg2 : qg3) + (i & 3);
      q0[qc] = f2bf(qv[i] * e0);
      q1[qc] = f2bf(qv[i] * e1);
      kd0[i * 64] = f2bf(kv[i] * f0);
      kd1[i * 64] = f2bf(kv[i] * f1);
    }
#pragma unroll
    for (int hf = 0; hf < 2; ++hf) {
      *(bf16x8*)(kn_s + t * 72 + q4 * 16 + hf * 8) = kpk[hf];
      *(bf16x8*)(qn_s + t * 72 + q4 * 16 + hf * 8) = qpk[hf];
      *(bf16x8*)(vT_s + t * 72 + q4 * 16 + hf * 8) = vpk[hf];
      *(bf16x8*)(knT_s + t * 72 + q4 * 16 + hf * 8) = kpk[hf];
    }
    if (tid == 0) {
      glbuf[it * 2] = gl0;
      glbuf[it * 2 + 1] = gl1;
    }
  }
  lds_barrier();
  {
    f32x4 c1[4], c2[4];
#pragma unroll
    for (int i = 0; i < 4; ++i) {
      c1[i] = f32x4{0.f, 0.f, 0.f, 0.f};
      c2[i] = f32x4{0.f, 0.f, 0.f, 0.f};
    }
#pragma unroll
    for (int ks = 0; ks < 2; ++ks) {
      bf16x8 a = *(const bf16x8*)(kn_s + (w * 16 + fr) * 72 + ks * 32 + fq * 8);
#pragma unroll
      for (int ni = 0; ni < 4; ++ni) {
        bf16x8 bq = *(const bf16x8*)(qn_s + (ni * 16 + fr) * 72 + ks * 32 + fq * 8);
        bf16x8 bk = *(const bf16x8*)(kn_s + (ni * 16 + fr) * 72 + ks * 32 + fq * 8);
        c1[ni] = mfma16(a, bq, c1[ni]);
        c2[ni] = mfma16(a, bk, c2[ni]);
      }
    }
    lds_barrier();
    LAUNDER(boff);
    base = (u16*)(p.ws + WS_R3) + boff;
#pragma unroll
    for (int ni = 0; ni < 4; ++ni) {
      int i = ni * 16 + fr;
      float gi0 = gt[i], gi1 = gt[64 + i], bi0 = bt[i], bi1 = bt[64 + i];
      int j0 = w * 16 + fq * 4;
      bf16x4 a0, a1;
#pragma unroll
      for (int r = 0; r < 4; ++r) {
        int j = j0 + r;
        float gj0 = gt[j], gj1 = gt[64 + j];
        float d0 = (i >= j) ? __expf(gi0 - gj0) : 0.f;
        float d1 = (i <= j) ? __expf(gi1 - gj1) : 0.f;
        a0[r] = (short)f2bf(c1[ni][r] * d0);
        a1[3 - r] = (short)f2bf(c1[ni][r] * d1);
        Amat[i * 65 + j] = (i > j) ? bi0 * c2[ni][r] * d0 : 0.f;
        Amat[4160 + (63 - i) * 65 + (63 - j)] = (i < j) ? bi1 * c2[ni][r] * d1 : 0.f;
      }
      *(bf16x4*)(base + 2 * 4096 + i * 64 + permg(j0)) = a0;
      *(bf16x4*)(base + 5 * 4096 + 2 * 4096 + (63 - i) * 64 + permg(60 - j0)) = a1;
    }
  }
  lds_barrier();
  if (w < 2) {
    float* Am = Amat + w * 4160;
    const int g = fq, c = fr;
    {
      float t[16];
      const float* Ab = Am + (g * 16) * 65 + g * 16;
#pragma unroll
      for (int i = 0; i < 16; ++i) {
        float acc = (i == c) ? 1.f : 0.f;
#pragma unroll
        for (int j = 0; j < i; ++j) acc -= Ab[i * 65 + j] * t[j];
        t[i] = acc;
      }
      float* Tw = Am + (g * 16) * 65 + g * 16 + c;
#pragma unroll
      for (int i = 0; i < 16; ++i) Tw[i * 65] = t[i];
    }
    for (int I = 1; I < 4; ++I)
      for (int J = 0; J < I; ++J) {
        f32x4 M = {0.f, 0.f, 0.f, 0.f};
        for (int K = J; K < I; ++K) {
#pragma unroll
          for (int s = 0; s < 4; ++s) {
            float a = Am[(I * 16 + fr) * 65 + K * 16 + 4 * s + g];
            float bb = Am[(K * 16 + 4 * s + g) * 65 + J * 16 + fr];
            M = __builtin_amdgcn_mfma_f32_16x16x4f32(a, bb, M, 0, 0, 0);
          }
        }
        f32x4 X = {0.f, 0.f, 0.f, 0.f};
#pragma unroll
        for (int s = 0; s < 4; ++s) {
          float a = Am[(I * 16 + fr) * 65 + I * 16 + 4 * g + s];
          X = __builtin_amdgcn_mfma_f32_16x16x4f32(a, M[s], X, 0, 0, 0);
        }
#pragma unroll
        for (int r = 0; r < 4; ++r) Am[(I * 16 + 4 * g + r) * 65 + J * 16 + fr] = -X[r];
      }
  }
  for (int dir = 0; dir < 2; ++dir) {
    u16* Tb = kn_s;
    u16* Tbg = kn_s + 4608;
    lds_barrier();
    LAUNDER(boff);
    base = (u16*)(p.ws + WS_R3) + boff;
    u16* bd = base + dir * 5 * 4096;
    for (int e = tid; e < 4096; e += 256) {
      int i = e >> 6, c = e & 63;
      float tv = Amat[dir * 4160 + i * 65 + c];
      if (dir == 0) {
        float bc = bt[c];
        float bg = bc * __expf(gt[c]);
        Tb[i * 72 + c] = f2bf(tv * bc);
        Tbg[i * 72 + c] = f2bf(tv * bg);
      } else {
        int tc = 63 - c;
        float bc = bt[64 + tc];
        float bg = bc * __expf(gt[64 + tc]);
        Tb[(63 - i) * 72 + tc] = f2bf(tv * bc);
        Tbg[(63 - i) * 72 + tc] = f2bf(tv * bg);
      }
    }
    lds_barrier();
    f32x4 cu[4], cw[4];
#pragma unroll
    for (int i = 0; i < 4; ++i) {
      cu[i] = f32x4{0.f, 0.f, 0.f, 0.f};
      cw[i] = f32x4{0.f, 0.f, 0.f, 0.f};
    }
#pragma unroll
    for (int ks = 0; ks < 2; ++ks) {
      bf16x8 aT = *(const bf16x8*)(Tb + (w * 16 + fr) * 72 + ks * 32 + fq * 8);
      typedef __attribute__((address_space(3))) bf16x4 lds_b4;
      const int trow = ks * 32 + fq * 8 + (fr >> 2), tcol = (fr & 3) * 4;
      bf16x8 aK;
      {
        const u16* sp = knT_s + trow * 72 + w * 16 + tcol;
        bf16x4 l4 = __builtin_amdgcn_ds_read_tr16_b64_v4i16((lds_b4*)sp);
        bf16x4 h4 = __builtin_amdgcn_ds_read_tr16_b64_v4i16((lds_b4*)(sp + 4 * 72));
        aK = bf16x8{l4[0], l4[1], l4[2], l4[3], h4[0], h4[1], h4[2], h4[3]};
      }
#pragma unroll
      for (int ni = 0; ni < 4; ++ni) {
        bf16x8 bv;
        {
          const u16* sp = vT_s + trow * 72 + ni * 16 + tcol;
          bf16x4 l4 = __builtin_amdgcn_ds_read_tr16_b64_v4i16((lds_b4*)sp);
          bf16x4 h4 = __builtin_amdgcn_ds_read_tr16_b64_v4i16((lds_b4*)(sp + 4 * 72));
          bv = bf16x8{l4[0], l4[1], l4[2], l4[3], h4[0], h4[1], h4[2], h4[3]};
        }
        bf16x8 bT = *(const bf16x8*)(Tbg + (ni * 16 + fr) * 72 + ks * 32 + fq * 8);
        cu[ni] = mfma16(aT, bv, cu[ni]);
        cw[ni] = mfma16(aK, bT, cw[ni]);
      }
    }
#pragma unroll
    for (int ni = 0; ni < 4; ++ni) {
      int d = ni * 16 + fr;
      int i0 = w * 16 + fq * 4;
      bf16x4 o;
      if (dir == 0) {
#pragma unroll
        for (int r = 0; r < 4; ++r) o[r] = (short)f2bf(cu[ni][r]);
        *(bf16x4*)(bd + 4 * 4096 + d * 64 + i0) = o;
      } else {
#pragma unroll
        for (int r = 0; r < 4; ++r) o[3 - r] = (short)f2bf(cu[ni][r]);
        *(bf16x4*)(bd + 4 * 4096 + d * 64 + 60 - i0) = o;
      }
      int i = ni * 16 + fr;
      int pp = dir ? 63 - i : i;
      int d0 = w * 16 + fq * 4;
      bf16x4 o2;
#pragma unroll
      for (int r = 0; r < 4; ++r) o2[r] = (short)f2bf(cw[ni][r]);
      *(bf16x4*)(bd + 0 * 4096 + pp * 64 + permg(d0)) = o2;
    }
  }
}

DEVI bf16x8 ldA(const u16* M, int mi, int ks, int fr, int fq) {
  const u16* q = M + (mi * 16 + fr) * 64 + ks * 32 + fq * 4;
  bf16x4 lo = *(const bf16x4*)q, hi = *(const bf16x4*)(q + 16);
  return bf16x8{lo[0], lo[1], lo[2], lo[3], hi[0], hi[1], hi[2], hi[3]};
}

DEVI bf16x8 ldL(const char* smem, int mat, int mi, int ks, int fr, int fq) {
  return *(const bf16x8*)(smem + (mat * 64 + mi * 16 + fr) * 144 + (ks * 32 + fq * 8) * 2);
}

__device__ void scan_item(const P& p, int l, int id, char* smem) {
  int tid = threadIdx.x;
  asm volatile("" : "+v"(tid));
  const int lane = tid & 63, w = tid >> 6, fr = lane & 15, fq = lane >> 4;
  const int latent = id < 64;
  const int cid = latent ? id : id - 64;
  const int b = cid >> 3, h = (cid >> 1) & 3, dir = cid & 1;
  const int tb = latent ? NCTX + b * 4096 : b * 256;
  const int N = latent ? 64 : 4;
  u16* z = (u16*)(p.ws + WS_Z);
  const float* glbuf = (const float*)(p.ws + WS_GL);
  const unsigned char* r3 = p.ws + WS_R3;
  f32x4 S[4];
  if (latent) {
    const float* s0 = p.state + ((size_t)(((b * 2 + l) * 2 + dir) * 4 + h)) * 4096;
#pragma unroll
    for (int mt = 0; mt < 4; ++mt)
#pragma unroll
      for (int r = 0; r < 4; ++r) S[mt][r] = s0[(mt * 16 + fq * 4 + r) * 64 + w * 16 + fr];
  } else {
#pragma unroll
    for (int mt = 0; mt < 4; ++mt) S[mt] = f32x4{0.f, 0.f, 0.f, 0.f};
  }
  __builtin_amdgcn_s_setprio(3);
  float eglv;
  {
    const int nn = lane < N ? lane : N - 1;
    const int cidx_ = dir ? N - 1 - nn : nn;
    const int it_ = ((tb + cidx_ * 64) >> 6) * 4 + h;
    eglv = __expf(glbuf[it_ * 2 + dir]);
  }
  bf16x8 R0[10], R1[10];
#define SC_ISSUE(R, nn)                                                      \
  {                                                                          \
    int n_ = (nn) < N ? (nn) : N - 1;                                        \
    int cidx_ = dir ? N - 1 - n_ : n_;                                       \
    int it_ = ((tb + cidx_ * 64) >> 6) * 4 + h;                              \
    const unsigned char* g_ = r3 + (size_t)(it_ * 2 + dir) * 40960 + tid * 16; \
    _Pragma("unroll") for (int j = 0; j < 10; ++j) R[j] = *(const bf16x8*)(g_ + j * 4096); \
  }
#define SC_STASH(R)                                                          \
  {                                                                          \
    _Pragma("unroll") for (int j = 0; j < 10; ++j) {                         \
      int c_ = tid + 256 * j;                                                \
      *(bf16x8*)(smem + (c_ >> 3) * 144 + (c_ & 7) * 16) = R[j];             \
    }                                                                        \
  }
  SC_ISSUE(R0, 0);
  SC_ISSUE(R1, 1);
  for (int n2 = 0; n2 < N; n2 += 2) {
#pragma unroll
    for (int half = 0; half < 2; ++half) {
      const int n = n2 + half;
      lds_barrier();
      if (half == 0) { SC_STASH(R0); } else { SC_STASH(R1); }
      lds_barrier();
      if (half == 0) { SC_ISSUE(R0, n + 2); } else { SC_ISSUE(R1, n + 2); }
      const int cidx = dir ? N - 1 - n : n;
      const int tok0 = tb + cidx * 64;
      const int it = (tok0 >> 6) * 4 + h;
      const float egl = __shfl(eglv, n);
      bf16x8 Sb[2];
#pragma unroll
      for (int ks = 0; ks < 2; ++ks)
#pragma unroll
        for (int e = 0; e < 8; ++e) Sb[ks][e] = (short)f2bf(S[2 * ks + (e >> 2)][e & 3]);
      f32x4 vn[4];
#pragma unroll
      for (int mi = 0; mi < 4; ++mi) {
        f32x4 acc = {0.f, 0.f, 0.f, 0.f};
#pragma unroll
        for (int ks = 0; ks < 2; ++ks) acc = mfma16(ldL(smem, 0, mi, ks, fr, fq), Sb[ks], acc);
        bf16x4 uu = *(const bf16x4*)(smem + (256 + w * 16 + fr) * 144 + (mi * 16 + fq * 4) * 2);
#pragma unroll
        for (int r = 0; r < 4; ++r) vn[mi][r] = bfs(uu[r]) - acc[r];
      }
      bf16x8 Vb[2];
#pragma unroll
      for (int ks = 0; ks < 2; ++ks)
#pragma unroll
        for (int e = 0; e < 8; ++e) Vb[ks][e] = (short)f2bf(vn[2 * ks + (e >> 2)][e & 3]);
      {
        const int colo = (dir ? CV : CK) + h * 64 + w * 16 + fq * 4;
        u16* zo = z + (size_t)(tok0 + (dir ? 63 - fr : fr)) * ZC + colo;
        const int rstep = dir ? -ZC : ZC;
#pragma unroll
        for (int mi = 0; mi < 4; ++mi) {
          f32x4 acc = {0.f, 0.f, 0.f, 0.f};
#pragma unroll
          for (int ks = 0; ks < 2; ++ks) acc = mfma16(Sb[ks], ldL(smem, 1, mi, ks, fr, fq), acc);
#pragma unroll
          for (int ks = 0; ks < 2; ++ks) acc = mfma16(Vb[ks], ldL(smem, 2, mi, ks, fr, fq), acc);
          bf16x4 o4;
#pragma unroll
          for (int r = 0; r < 4; ++r) o4[r] = (short)f2bf(acc[r]);
          *(bf16x4*)(zo + (mi * 16) * rstep) = o4;
        }
      }
#pragma unroll
      for (int mt = 0; mt < 4; ++mt) {
        f32x4 acc = S[mt] * egl;
#pragma unroll
        for (int ks = 0; ks < 2; ++ks) acc = mfma16(ldL(smem, 3, mt, ks, fr, fq), Vb[ks], acc);
        S[mt] = acc;
      }
    }
  }
#undef SC_ISSUE
#undef SC_STASH
  __builtin_amdgcn_s_setprio(0);
  if (!latent) {
    float* dst = p.out + OFF_ST + ((size_t)(((b * 2 + l) * 2 + dir) * 4 + h)) * 4096;
#pragma unroll
    for (int mt = 0; mt < 4; ++mt)
#pragma unroll
      for (int r = 0; r < 4; ++r) dst[(mt * 16 + fq * 4 + r) * 64 + w * 16 + fr] = S[mt][r];
  }
}

__device__ void fin_phase(const P& p, int l) {
  int tid = threadIdx.x;
  asm volatile("" : "+v"(tid));
  const int lane = tid & 63, wv = tid >> 6;
  u16* z = (u16*)(p.ws + WS_Z);
  const int c = lane * 4;
  float ngv[4];
#pragma unroll
  for (int k = 0; k < 4; ++k) ngv[k] = p.norm_g[l * 64 + (c & 63) + k];
  for (int it = blockIdx.x; it < 2560; it += gridDim.x) {
    const int row0 = it * 16 + wv * 4;
    bf16x4 of[4], ob[4], cg4[4];
#pragma unroll
    for (int rr = 0; rr < 4; ++rr) {
      const u16* zr = z + (size_t)(row0 + rr) * ZC;
      of[rr] = *(const bf16x4*)(zr + CK + c);
      ob[rr] = *(const bf16x4*)(zr + CV + c);
      cg4[rr] = *(const bf16x4*)(zr + CG + c);
    }
#pragma unroll
    for (int rr = 0; rr < 4; ++rr) {
      float o[4];
      float ss = 0.f;
#pragma unroll
      for (int k = 0; k < 4; ++k) {
        o[k] = bfs(of[rr][k]) + bfs(ob[rr][k]);
        ss += o[k] * o[k];
      }
      ss += __shfl_xor(ss, 1);
      ss += __shfl_xor(ss, 2);
      ss += __shfl_xor(ss, 4);
      ss += __shfl_xor(ss, 8);
      float rstd = rsqrtf(ss * (1.f / 64.f) + EPS);
      bf16x4 ov;
#pragma unroll
      for (int k = 0; k < 4; ++k) ov[k] = (short)f2bf(o[k] * rstd * ngv[k] * silu(bfs(cg4[rr][k])));
      *(bf16x4*)(z + (size_t)(row0 + rr) * ZC + CQ + c) = ov;
    }
  }
}

__device__ void mixed_phase(const P& p, int l, char* smem, int mask) {
  int* ctr = (int*)(p.ws + WS_CTR);
  int* sitem = (int*)(smem + SITEM_OFF);
  const int x0 = (int)(xb_xcc_id() & 7u);
  for (int dx = 0; dx < 8; ++dx) {
    const int x = (x0 + dx) & 7;
    int* c = ctr + (l * 8 + x) * 16;
    for (;;) {
      __syncthreads();
      if (threadIdx.x == 0) *sitem = atomicAdd(c, 1);
      __syncthreads();
      const int j = __builtin_amdgcn_readfirstlane(*sitem);
      if (j >= 520) break;
      if (j < 8)
        scan_item(p, l, x * 8 + j, smem);
      else if (j < 40)
        scan_item(p, l, 64 + x * 32 + (j - 8), smem);
      else if (j < 296)
        attn_item(p, l, x * 256 + (j - 40), smem, ((mask >> 9) & 1) ? 2 : 1);
      else if (j < 360)
        attn_item(p, l, 2048 + x * 64 + (j - 296), smem, ((mask >> 9) & 1) ? 2 : 1);
      else
        sgu_item(p, l, x * 160 + (j - 360), smem);
    }
  }
}

__device__ void run_phase(const P& p, int ph, char* smem, int mask) {
  if (ph == 0) {
    phase0(p, smem);
  } else if (ph == 1) {
    row_phase(p, 0);
  } else {
    int l = (ph - 2) / 6, s = (ph - 2) % 6;
    if (s == 0)
      gemm_phase<0>(p, l, smem);
    else if (s == 1) {
      for (int it = blockIdx.x; it < 2560; it += gridDim.x) {
        __syncthreads();
        gdnpre_item(p, l, it, smem);
      }
    } else if (s == 2)
      mixed_phase(p, l, smem, mask);
    else if (s == 3)
      fin_phase(p, l);
    else if (s == 4)
      gemm_phase<1>(p, l, smem);
    else
      row_phase(p, 1 + l);
  }
}

__global__ void __launch_bounds__(256, 2) mega(P p, int ph0, int ph1, int mask) {
  extern __shared__ __align__(16) char smem[];
  volatile LAS unsigned* st = (volatile LAS unsigned*)(smem + XBST_OFF);
  if (threadIdx.x == 0) {
    st[0] = 0u;
    st[1] = 0u;
  }
  __syncthreads();
  XcdBarrier xb = xcd_barrier_post((unsigned*)(p.ws + WS_BAR), st);
  if (mask == 0x40000000) cg::this_grid().sync();
  for (int ph = ph0; ph < ph1; ++ph) {
    int s_ = ph < 2 ? 6 + ph : (ph - 2) % 6;
    int reps = (((mask >> s_) & 1) && ph != 13) ? 2 : 1;
    for (int r = 0; r < reps; ++r) {
      run_phase(p, ph, smem, mask);
      if (r + 1 < reps || ph + 1 < ph1) xcd_barrier(xb);
    }
  }
}

extern "C" void kernel_launch(void* const* d_in, const int* in_sizes, int n_in, void* d_out, int out_size, void* d_ws,
                              size_t ws_size, hipStream_t stream) {
  static int grid_blocks = 0;
  if (!grid_blocks) {
    hipFuncSetAttribute((const void*)mega, hipFuncAttributeMaxDynamicSharedMemorySize, SMEM_BYTES);
    int dev = 0, cus = 0, per_cu = 0;
    hipGetDevice(&dev);
    hipDeviceGetAttribute(&cus, hipDeviceAttributeMultiprocessorCount, dev);
    hipOccupancyMaxActiveBlocksPerMultiprocessor(&per_cu, mega, 256, SMEM_BYTES);
    if (per_cu < 1) per_cu = 1;
    if (per_cu > 2) per_cu = 2;
    grid_blocks = cus * per_cu;
    if (ws_size < WS_END + 16384) fprintf(stderr, "workspace too small: %zu < %zu\n", ws_size, (size_t)WS_END);
  }
  P p{};
  const float** pp = (const float**)&p;
  for (int i = 0; i < 22; ++i) pp[i] = (const float*)d_in[i];
  p.out = (float*)d_out;
  p.ws = (unsigned char*)d_ws;
  hipMemsetAsync(d_ws, 0, 4096, stream);
  hipMemsetAsync((char*)d_ws + WS_BAR, 0, 16384, stream);
  const int NPH = 14;
#if ONE_LAUNCH
  int ph0 = 0, ph1 = NPH;
  int mask = PROBE_MASK;
  void* args[] = {&p, &ph0, &ph1, &mask};
  static int tried2 = 0;
  hipError_t e;
  if (!tried2) {
    tried2 = 1;
    int dev = 0, cus = 0;
    hipGetDevice(&dev);
    hipDeviceGetAttribute(&cus, hipDeviceAttributeMultiprocessorCount, dev);
    if (grid_blocks < cus * 2) {
      e = hipLaunchCooperativeKernel((const void*)mega, dim3(cus * 2), dim3(256), args, SMEM_BYTES, stream);
      if (e == hipSuccess) {
        grid_blocks = cus * 2;
        return;
      }
      (void)hipGetLastError();
    }
  }
  e = hipLaunchCooperativeKernel((const void*)mega, dim3(grid_blocks), dim3(256), args, SMEM_BYTES, stream);
  if (e != hipSuccess) fprintf(stderr, "cooperative launch failed: %s (grid %d)\n", hipGetErrorString(e), grid_blocks);
#else
  for (int ph = 0; ph < NPH; ++ph) mega<<<grid_blocks, 256, SMEM_BYTES, stream>>>(p, ph, ph + 1, 0);
#endif
}
```

```cpp
#include <hip/hip_runtime.h>
#include <hip/hip_cooperative_groups.h>
#include <cstdio>
namespace cg = cooperative_groups;

#ifndef ONE_LAUNCH
#define ONE_LAUNCH 1
#ifndef PROBE_MASK
#define PROBE_MASK 0
#endif
#endif

typedef unsigned short u16;
using bf16x8 = __attribute__((ext_vector_type(8))) short;
using bf16x4 = __attribute__((ext_vector_type(4))) short;
using f32x4 = __attribute__((ext_vector_type(4))) float;
using f32x16 = __attribute__((ext_vector_type(16))) float;
#define DEVI __device__ __forceinline__
#define LAUNDER(p) asm volatile("" : "+v"(p))
DEVI void lds_barrier() { asm volatile("s_waitcnt lgkmcnt(0)\n\ts_barrier" ::: "memory"); }

constexpr int NCTX = 8192, ZC = 3088;
constexpr int AQ = 0, AK = 512, AV = 640, AG = 768, BU = 1280, BV = 1536, BG = 1792, CQ = 2048, CK = 2304,
              CV = 2560, CA = 2816, CB = 2824, CG = 2832;
constexpr float EPS = 1e-6f;
constexpr size_t WS_CTR = 0, WS_MOD = 4096, WS_ROPE = 225280, WS_GL = 233472, WS_PART = 253952,
                 WS_SGUW = 2875392, WS_WOUT = 3137536, WS_WIN = 7331840, WS_Z = 20439040,
                 WS_R3 = 273408000, WS_END = 483123200, MIXOFF = 83886080;
constexpr size_t OFF_CK = 41943040, OFF_CV = 44040192, OFF_ST = 46137344;
constexpr int SMEM_BYTES = 77824;
constexpr int SITEM_OFF = 77808;
constexpr int XBST_OFF = 77776;
constexpr size_t WS_BAR = 483123200;

struct P {
  const float *xp, *xs, *cache_k, *cache_v, *state, *c, *cctx, *w_mod, *b_mod, *g_pre, *w_in, *sink, *ln_g,
      *ln_b, *sgu_w, *sgu_b, *conv_w, *a_log, *dt_bias, *norm_g, *g_post, *w_out;
  float* out;
  unsigned char* ws;
};

DEVI u16 f2bf(float f) {
  __bf16 b = (__bf16)f;
  return __builtin_bit_cast(u16, b);
}
DEVI int permg(int k0) { return (k0 & 32) | ((k0 & 12) << 1) | ((k0 & 16) >> 2); }
DEVI float bf2f(u16 h) { return __uint_as_float(((unsigned)h) << 16); }
DEVI float bfs(short h) { return __uint_as_float(((unsigned)(u16)h) << 16); }
DEVI float silu(float x) { return x * __builtin_amdgcn_rcpf(1.f + __expf(-x)); }
DEVI f32x4 mfma16(bf16x8 a, bf16x8 b, f32x4 c) { return __builtin_amdgcn_mfma_f32_16x16x32_bf16(a, b, c, 0, 0, 0); }
DEVI f32x16 mfma32(bf16x8 a, bf16x8 b, f32x16 c) { return __builtin_amdgcn_mfma_f32_32x32x16_bf16(a, b, c, 0, 0, 0); }


#define XB_TMO 128
#define XB_XCNT(j) (256 + 64 * (j))
#define XB_XSUB(j) (1280 + 64 * (j))
#define XB_XGEN(j) (2304 + 64 * (j))
#define XB_TOP 3328
#define XB_TOPGEN 3392
#define XB_SPIN_CAP (1u << 18)
#define LAS __attribute__((address_space(3)))
DEVI unsigned xb_ld(unsigned* p) { return __hip_atomic_load(p, __ATOMIC_RELAXED, __HIP_MEMORY_SCOPE_AGENT); }
DEVI unsigned xb_add(unsigned* p, unsigned v) { return __hip_atomic_fetch_add(p, v, __ATOMIC_RELAXED, __HIP_MEMORY_SCOPE_AGENT); }
DEVI unsigned xb_xcc_id() { return (unsigned)__builtin_amdgcn_s_getreg((3 << 11) | 20) & 0xFu; }
#define XB_SPIN(cond, bar)                                   \
  do {                                                       \
    unsigned _sp = 0;                                        \
    while (cond) {                                           \
      __builtin_amdgcn_s_sleep(1);                           \
      if ((++_sp & 255u) == 0u) {                            \
        if (xb_ld(&(bar)[XB_TMO])) break;                    \
        if (_sp > XB_SPIN_CAP) {                             \
          atomicAdd(&(bar)[XB_TMO], 1u);                     \
          break;                                             \
        }                                                    \
      }                                                      \
    }                                                        \
  } while (0)
struct XcdBarrier {
  unsigned* bar;
  unsigned x;
  volatile LAS unsigned* st;
};
DEVI XcdBarrier xcd_barrier_post(unsigned* bar, volatile LAS unsigned* st) {
  XcdBarrier b;
  b.bar = bar;
  b.x = xb_xcc_id();
  b.st = st;
  if (threadIdx.x == 0) (void)xb_add(&bar[XB_XCNT(b.x)], 1u);
  return b;
}
DEVI void xcd_barrier_complete(unsigned* bar, unsigned x, unsigned& nloc, unsigned& nx) {
  const unsigned G = gridDim.x * gridDim.y * gridDim.z;
  unsigned sum, cnt, mine, sp = 0u;
  for (;;) {
    sum = 0u;
    cnt = 0u;
    mine = 0u;
#pragma unroll
    for (unsigned j = 0; j < 16; ++j) {
      const unsigned c = xb_ld(&bar[XB_XCNT(j)]);
      sum += c;
      cnt += (c > 0u) ? 1u : 0u;
      mine = (j == x) ? c : mine;
    }
    if (sum == G) break;
    __builtin_amdgcn_s_sleep(1);
    if ((++sp & 255u) == 0u) {
      if (xb_ld(&bar[XB_TMO])) break;
      if (sp > XB_SPIN_CAP) {
        atomicAdd(&bar[XB_TMO], 1u);
        break;
      }
    }
  }
  nloc = mine > 0u ? mine : 1u;
  nx = cnt > 0u ? cnt : 1u;
}
DEVI void xcd_barrier(const XcdBarrier& b) {
  asm volatile("s_waitcnt vmcnt(0)" ::: "memory");
  __syncthreads();
  if (threadIdx.x == 0) {
    unsigned* bar = b.bar;
    __builtin_amdgcn_s_waitcnt(0);
    unsigned nloc = b.st[0], nx = b.st[1];
    if (nloc == 0u) {
      xcd_barrier_complete(bar, b.x, nloc, nx);
      b.st[0] = nloc;
      b.st[1] = nx;
    }
    const unsigned old = xb_add(&bar[XB_XSUB(b.x)], 1u);
    const unsigned gen = old / nloc;
    if (old + 1u == (gen + 1u) * nloc) {
      __builtin_amdgcn_fence(__ATOMIC_RELEASE, "agent");
      asm volatile("s_waitcnt vmcnt(0)" ::: "memory");
      const unsigned og = xb_add(&bar[XB_TOP], 1u);
      const unsigned tg = og / nx;
      if (og + 1u == (tg + 1u) * nx)
        xb_add(&bar[XB_TOPGEN], 1u);
      else
        XB_SPIN(xb_ld(&bar[XB_TOPGEN]) == tg, bar);
      __builtin_amdgcn_fence(__ATOMIC_ACQUIRE, "agent");
      xb_add(&bar[XB_XGEN(b.x)], 1u);
      asm volatile("s_waitcnt vmcnt(0)" ::: "memory");
    } else {
      XB_SPIN(xb_ld(&bar[XB_XGEN(b.x)]) == gen, bar);
      __builtin_amdgcn_fence(__ATOMIC_ACQUIRE, "agent");
      asm volatile("s_waitcnt vmcnt(0)" ::: "memory");
    }
  }
  __syncthreads();
}

__device__ void phase0(const P& p, char* smem) {
  const int tid = threadIdx.x;
  float* mod = (float*)(p.ws + WS_MOD);
  for (int it = blockIdx.x; it < 2337; it += gridDim.x) {
    __syncthreads();
    if (it < 192) {
      int l = it / 96, c0 = (it % 96) * 32;
      float* sc = (float*)smem;
      for (int e = tid; e < 9 * 1024; e += 256) {
        int j = e >> 10, k = e & 1023;
        float v = j == 0 ? p.cctx[k] : p.c[(j - 1) * 1024 + k];
        sc[e] = silu(v);
      }
      __syncthreads();
      int col = tid & 31, kp = tid >> 5;
      float acc[9];
#pragma unroll
      for (int j = 0; j < 9; ++j) acc[j] = 0.f;
      const float* w = p.w_mod + (size_t)l * 1024 * 3072 + c0 + col;
#pragma unroll 8
      for (int k = kp * 128; k < kp * 128 + 128; ++k) {
        float wv = w[(size_t)k * 3072];
#pragma unroll
        for (int j = 0; j < 9; ++j) acc[j] += sc[j * 1024 + k] * wv;
      }
      float* red = (float*)(smem + 36864);
#pragma unroll
      for (int j = 0; j < 9; ++j) red[(kp * 9 + j) * 32 + col] = acc[j];
      __syncthreads();
      for (int e = tid; e < 288; e += 256) {
        int j = e / 32, cc = e % 32;
        float s = p.b_mod[l * 3072 + c0 + cc];
        for (int k2 = 0; k2 < 8; ++k2) s += red[(k2 * 9 + j) * 32 + cc];
        mod[(l * 9 + j) * 3072 + c0 + cc] = s;
      }
    } else if (it < 192 + 1600 + 512) {
      int r = it - 192;
      const float* src;
      u16* dst;
      int ncols, nvalid, n0, k0;
      if (r < 1600) {
        int l = r / 800;
        r %= 800;
        n0 = (r / 16) * 64;
        k0 = (r % 16) * 64;
        src = p.w_in + (size_t)l * 1024 * 3088;
        dst = (u16*)(p.ws + WS_WIN) + (size_t)l * 3200 * 1024;
        ncols = 3088;
        nvalid = 3088;
      } else {
        r -= 1600;
        int l = r / 256;
        r %= 256;
        n0 = (r / 16) * 64;
        k0 = (r % 16) * 64;
        src = p.w_out + (size_t)l * 1024 * 1024;
        dst = (u16*)(p.ws + WS_WOUT) + (size_t)l * 1024 * 1024;
        ncols = 1024;
        nvalid = 1024;
      }
      float* tile = (float*)smem;
      int nn = tid & 63;
      for (int i = 0; i < 16; ++i) {
        int kk = (tid >> 6) + 4 * i;
        float v = 0.f;
        if (n0 + nn < nvalid) v = src[(size_t)(k0 + kk) * ncols + n0 + nn];
        tile[kk * 65 + nn] = v;
      }
      __syncthreads();
      int kk2 = tid & 63;
      for (int i = 0; i < 16; ++i) {
        int nn2 = (tid >> 6) + 4 * i;
        dst[(size_t)(n0 + nn2) * 1024 + k0 + kk2] = f2bf(tile[kk2 * 65 + nn2]);
      }
    } else if (it < 192 + 1600 + 512 + 32) {
      int r = it - (192 + 1600 + 512);
      u16* d = (u16*)(p.ws + WS_SGUW);
      for (int i = 0; i < 16; ++i) {
        int e = r * 4096 + i * 256 + tid;
        d[e] = f2bf(p.sgu_w[e]);
      }
    } else {
      float* rc = (float*)(p.ws + WS_ROPE);
      for (int i = 0; i < 4; ++i) {
        int e = i * 256 + tid;
        int pos = e >> 4, f = e & 15;
        float inv = powf(10000.f, -(float)f / 16.f);
        float ang = (float)pos * inv;
        rc[e] = cosf(ang);
        rc[1024 + e] = sinf(ang);
      }
    }
  }
}

__device__ void row_phase(const P& p, int mode) {
  int tid = threadIdx.x;
  asm volatile("" : "+v"(tid));
  const int lane = tid & 63, wv = tid >> 6;
  const float* mod = (const float*)(p.ws + WS_MOD);
  for (int it = blockIdx.x; it < 5120; it += gridDim.x) {
    const int rowb = it * 8 + wv * 2;
    float4 x[2][4];
    bf16x4 mv[2][4];
    float ssp[2];
#pragma unroll
    for (int rr = 0; rr < 2; ++rr) {
      const int row = rowb + rr;
      const float* xin = row < NCTX ? p.xp + (size_t)row * 1024 : p.xs + (size_t)(row - NCTX) * 1024;
      const float* yout = p.out + (size_t)row * 1024;
#pragma unroll
      for (int i = 0; i < 4; ++i)
      {
        typedef float f4v __attribute__((ext_vector_type(4)));
        const f4v* sp_ = (mode == 2) ? (const f4v*)yout : (const f4v*)xin;
        f4v t_ = __builtin_nontemporal_load(sp_ + i * 64 + lane);
        x[rr][i] = make_float4(t_[0], t_[1], t_[2], t_[3]);
      }
      if (mode >= 1) {
        const u16* mix = (const u16*)(p.ws + WS_R3 + MIXOFF) + (size_t)row * 1024;
#pragma unroll
        for (int i = 0; i < 4; ++i) mv[rr][i] = __builtin_nontemporal_load((const bf16x4*)(mix + (i * 64 + lane) * 4));
        const float* part = (const float*)(p.ws + WS_PART) + (size_t)row * 16;
        float4 p0 = ((const float4*)part)[0], p1 = ((const float4*)part)[1], p2 = ((const float4*)part)[2],
               p3 = ((const float4*)part)[3];
        ssp[rr] = ((p0.x + p0.y) + (p0.z + p0.w)) + ((p1.x + p1.y) + (p1.z + p1.w)) + ((p2.x + p2.y) + (p2.z + p2.w)) +
                  ((p3.x + p3.y) + (p3.z + p3.w));
      }
    }
#pragma unroll
    for (int rr = 0; rr < 2; ++rr) {
      const int row = rowb + rr;
      const int cond = row < NCTX ? 0 : 1 + ((row - NCTX) >> 12);
      float* yout = p.out + (size_t)row * 1024;
      if (mode >= 1) {
        const int l = mode - 1;
        const float rstd = rsqrtf(ssp[rr] * (1.f / 1024.f) + EPS);
        const float* gate = mod + (size_t)(l * 9 + cond) * 3072 + 2048;
        const float* gp = p.g_post + l * 1024;
#pragma unroll
        for (int i = 0; i < 4; ++i) {
          int c = (i * 64 + lane) * 4;
          float4 g4 = *(const float4*)(gate + c);
          float4 p4 = *(const float4*)(gp + c);
          x[rr][i].x += g4.x * bfs(mv[rr][i][0]) * rstd * p4.x;
          x[rr][i].y += g4.y * bfs(mv[rr][i][1]) * rstd * p4.y;
          x[rr][i].z += g4.z * bfs(mv[rr][i][2]) * rstd * p4.z;
          x[rr][i].w += g4.w * bfs(mv[rr][i][3]) * rstd * p4.w;
          {
            typedef float f4v __attribute__((ext_vector_type(4)));
            f4v t_ = {x[rr][i].x, x[rr][i].y, x[rr][i].z, x[rr][i].w};
            __builtin_nontemporal_store(t_, (f4v*)yout + i * 64 + lane);
          }
        }
      }
      if (mode <= 1) {
        const int l = mode;
        float ss = 0.f;
#pragma unroll
        for (int i = 0; i < 4; ++i)
          ss += x[rr][i].x * x[rr][i].x + x[rr][i].y * x[rr][i].y + x[rr][i].z * x[rr][i].z + x[rr][i].w * x[rr][i].w;
#pragma unroll
        for (int o = 1; o < 64; o <<= 1) ss += __shfl_xor(ss, o);
        const float rstd = rsqrtf(ss * (1.f / 1024.f) + EPS);
        const float* md = mod + (size_t)(l * 9 + cond) * 3072;
        const float* gpre = p.g_pre + l * 1024;
        u16* h = (u16*)(p.ws + WS_R3) + (size_t)row * 1024;
#pragma unroll
        for (int i = 0; i < 4; ++i) {
          int c = (i * 64 + lane) * 4;
          float4 g4 = *(const float4*)(gpre + c);
          float4 sh = *(const float4*)(md + c);
          float4 sc = *(const float4*)(md + 1024 + c);
          bf16x4 o;
          o[0] = (short)f2bf(x[rr][i].x * rstd * g4.x * (1.f + sc.x) + sh.x);
          o[1] = (short)f2bf(x[rr][i].y * rstd * g4.y * (1.f + sc.y) + sh.y);
          o[2] = (short)f2bf(x[rr][i].z * rstd * g4.z * (1.f + sc.z) + sh.z);
          o[3] = (short)f2bf(x[rr][i].w * rstd * g4.w * (1.f + sc.w) + sh.w);
          *(bf16x4*)(h + c) = o;
        }
      }
    }
  }
}

template <int MODE>
__device__ void gemm_phase(const P& p, int l, char* smem) {
  int tid = threadIdx.x;
  asm volatile("" : "+v"(tid));
  const int lane = tid & 63, wv = tid >> 6, wr = wv >> 1, wc = wv & 1, fr = lane & 15,
            fq = lane >> 4;
  u16* As = (u16*)smem;
  u16* Bs = (u16*)(smem + 18432);
  const u16* A = MODE == 0 ? (const u16*)(p.ws + WS_R3) : (const u16*)(p.ws + WS_Z);
  const int lda = MODE == 0 ? 1024 : ZC;
  const u16* Bt = MODE == 0 ? (const u16*)(p.ws + WS_WIN) + (size_t)l * 3200 * 1024
                            : (const u16*)(p.ws + WS_WOUT) + (size_t)l * 1024 * 1024;
  const int NT = MODE == 0 ? 25 : 8;
  const int ntiles = 320 * NT;
  const int lrow = tid >> 3, lseg = tid & 7;
  u16* z = (u16*)(p.ws + WS_Z);
  const int NG8 = NT / 8, ngmain = 40 * NG8, ngroups = ngmain + ((NT % 8) ? 5 : 0);
  (void)ntiles;
  int aoff[4], boff[4];
#pragma unroll
  for (int i = 0; i < 4; ++i) {
    const int bb = tid * 16 + i * 4096;
    const int st = bb >> 10, sb = bb & 1023, swz = sb ^ (((sb >> 9) & 1) << 5);
    const int R = (st >> 1) * 16 + (swz >> 6), C = (st & 1) * 32 + ((swz & 63) >> 1);
    aoff[i] = R * lda + C;
    boff[i] = R * 1024 + C;
  }
  const int flo = (fr * 64 + fq * 16) ^ ((fr >> 3) << 5);
  int* gctr = (int*)(p.ws + WS_CTR) + 256 + ((l * 2 + MODE) * 8) * 16;
  int* sitem = (int*)(smem + SITEM_OFF);
  const int x0 = (int)(xb_xcc_id() & 7u);
  for (int dx = 0; dx < 8; ++dx)
  for (;;) {
    const int xq = (x0 + dx) & 7;
    __syncthreads();
    if (threadIdx.x == 0) *sitem = atomicAdd(gctr + xq * 16, 1);
    __syncthreads();
    const int sq = __builtin_amdgcn_readfirstlane(*sitem);
    const int g = xq + 8 * (sq >> 6), idx = sq & 63;
    if (g >= ngroups) break;
    int mt, nt;
    if (g < ngmain) {
      mt = (g / NG8) * 8 + (idx & 7);
      nt = (g % NG8) * 8 + (idx >> 3);
    } else {
      mt = (g - ngmain) * 64 + idx;
      nt = NT - 1;
    }
    int m0 = mt * 128, n0 = nt * 128;
    f32x4 acc[4][4];
#pragma unroll
    for (int i = 0; i < 4; ++i)
#pragma unroll
      for (int j = 0; j < 4; ++j) acc[i][j] = f32x4{0.f, 0.f, 0.f, 0.f};
#define GDMA(kt, stg)                                                                              \
  {                                                                                                \
    int k0_ = (kt) * 64;                                                                           \
    int ka_ = MODE == 0 ? k0_ : (k0_ < 512 ? k0_ : (k0_ < 768 ? BU + k0_ - 512 : CQ + k0_ - 768)); \
    const u16* Ab_ = A + (size_t)m0 * lda + ka_;                                                   \
    const u16* Bb_ = Bt + (size_t)n0 * 1024 + k0_;                                                 \
    char* sd_ = smem + (stg) * 32768 + tid * 16;                                                   \
    _Pragma("unroll") for (int i = 0; i < 4; ++i) {                                                \
      __builtin_amdgcn_global_load_lds((const unsigned*)(Ab_ + aoff[i]), (unsigned*)(sd_ + i * 4096), 16, 0, 0); \
      __builtin_amdgcn_global_load_lds((const unsigned*)(Bb_ + boff[i]), (unsigned*)(sd_ + 16384 + i * 4096), 16, 0, 0); \
    }                                                                                              \
  }
    lds_barrier();
    GDMA(0, 0);
    for (int kt = 0; kt < 16; ++kt) {
      asm volatile("s_waitcnt vmcnt(0)" ::: "memory");
      lds_barrier();
      if (kt + 1 < 16) GDMA(kt + 1, (kt + 1) & 1);
      const char* stA = smem + (kt & 1) * 32768 + flo;
      const char* stB = stA + 16384;
#pragma unroll
      for (int ks = 0; ks < 2; ++ks) {
        bf16x8 a[4], b[4];
#pragma unroll
        for (int i = 0; i < 4; ++i) {
          a[i] = *(const bf16x8*)(stA + ((wr * 4 + i) * 2 + ks) * 1024);
          b[i] = *(const bf16x8*)(stB + ((wc * 4 + i) * 2 + ks) * 1024);
        }
#pragma unroll
        for (int mi = 0; mi < 4; ++mi)
#pragma unroll
          for (int ni = 0; ni < 4; ++ni) acc[mi][ni] = mfma16(b[ni], a[mi], acc[mi][ni]);
      }
    }
#undef GDMA
    if (MODE == 0) {
      const bool latent = m0 >= NCTX;
      const bool dorope = latent && nt < 5;
      const float* ropec = (const float*)(p.ws + WS_ROPE);
      const float* ropes = ropec + 1024;
#pragma unroll
      for (int mi = 0; mi < 4; ++mi) {
        const int row = m0 + wr * 64 + mi * 16 + fr;
        f32x4 v0 = acc[mi][0], v1 = acc[mi][1], v2 = acc[mi][2], v3 = acc[mi][3];
        if (dorope) {
          const int pos = (row - NCTX) & 4095;
          const int pr = pos >> 6, pc = pos & 63;
          const float4 c0 = *(const float4*)(ropec + pr * 16 + fq * 4), s0 = *(const float4*)(ropes + pr * 16 + fq * 4);
          const float4 c1 = *(const float4*)(ropec + pc * 16 + fq * 4), s1 = *(const float4*)(ropes + pc * 16 + fq * 4);
          const float cc0[4] = {c0.x, c0.y, c0.z, c0.w}, ss0[4] = {s0.x, s0.y, s0.z, s0.w};
          const float cc1[4] = {c1.x, c1.y, c1.z, c1.w}, ss1[4] = {s1.x, s1.y, s1.z, s1.w};
#pragma unroll
          for (int r = 0; r < 4; ++r) {
            float t0 = v0[r] * cc0[r] - v1[r] * ss0[r], t1 = v1[r] * cc0[r] + v0[r] * ss0[r];
            v0[r] = t0;
            v1[r] = t1;
            float t2 = v2[r] * cc1[r] - v3[r] * ss1[r], t3 = v3[r] * cc1[r] + v2[r] * ss1[r];
            v2[r] = t2;
            v3[r] = t3;
          }
        }
        const int cb = n0 + wc * 64 + fq * 4;
        u16* zr = z + (size_t)row * ZC;
        const f32x4 vv[4] = {v0, v1, v2, v3};
#pragma unroll
        for (int ni = 0; ni < 4; ++ni) {
          if (cb + ni * 16 < ZC) {
            bf16x4 o;
#pragma unroll
            for (int r = 0; r < 4; ++r) o[r] = (short)f2bf(vv[ni][r]);
            *(bf16x4*)(zr + cb + ni * 16) = o;
          }
        }
        if (!latent && (nt == 4 || nt == 5)) {
          float* dst = p.out + (nt == 4 ? OFF_CK : OFF_CV) + ((size_t)((row >> 8) * 2 + l) * 256 + (row & 255)) * 128 +
                       (wc * 64 + fq * 4);
#pragma unroll
          for (int ni = 0; ni < 4; ++ni)
            *(float4*)(dst + ni * 16) = make_float4(vv[ni][0], vv[ni][1], vv[ni][2], vv[ni][3]);
        }
      }
    } else {
      u16* mix = (u16*)(p.ws + WS_R3 + MIXOFF);
      float* part = (float*)(p.ws + WS_PART);
#pragma unroll
      for (int mi = 0; mi < 4; ++mi) {
        const int row = m0 + wr * 64 + mi * 16 + fr;
        float ss = 0.f;
#pragma unroll
        for (int ni = 0; ni < 4; ++ni) {
          bf16x4 o;
#pragma unroll
          for (int r = 0; r < 4; ++r) {
            float v = acc[mi][ni][r];
            ss += v * v;
            o[r] = (short)f2bf(v);
          }
          *(bf16x4*)(mix + (size_t)row * 1024 + n0 + wc * 64 + ni * 16 + fq * 4) = o;
        }
        ss += __shfl_xor(ss, 16);
        ss += __shfl_xor(ss, 32);
        if (fq == 0) part[(size_t)row * 16 + nt * 2 + wc] = ss;
      }
    }
  }
}

__device__ void attn_item(const P& p, int l, int it, char* smem, int reps) {
  int tid = threadIdx.x;
  asm volatile("" : "+v"(tid));
  const int lane = tid & 63, w = tid >> 6, ql = lane & 31, hh = lane >> 5;
  u16* Ks = (u16*)smem;
  u16* Vt = (u16*)(smem + 9216);
  u16* z = (u16*)(p.ws + WS_Z);
  int b, qb, head, tb, latent;
  if (it < 2048) {
    latent = 1;
    b = it >> 8;
    qb = (it >> 3) & 31;
    head = it & 7;
    tb = NCTX + b * 4096;
  } else {
    int j = it - 2048;
    latent = 0;
    b = j >> 4;
    qb = (j >> 3) & 1;
    head = j & 7;
    tb = b * 256;
  }
  const int kvh = head >> 2;
  const int qpos = qb * 128 + w * 32 + ql;
  const size_t qrow = (size_t)(tb + qpos);
  bf16x8 qf[4];
#pragma unroll
  for (int ks = 0; ks < 4; ++ks) qf[ks] = *(const bf16x8*)(z + qrow * ZC + AQ + head * 64 + ks * 16 + hh * 8);
  float m, lsum;
  f32x16 oacc[2];
  for (int rep_ = 0; rep_ < reps; ++rep_) {
  m = p.sink[l * 8 + head] * 1.4426950408889634f;
  lsum = hh == 0 ? 1.f : 0.f;
#pragma unroll
  for (int d = 0; d < 2; ++d)
#pragma unroll
    for (int r = 0; r < 16; ++r) oacc[d][r] = 0.f;
  int kt0, kt1;
  if (latent) {
    kt0 = max(0, qb * 2 - 2);
    kt1 = min(63, qb * 2 + 3);
  } else {
    kt0 = 0;
    kt1 = 3;
  }
  const int nwin = kt1 - kt0 + 1;
  const int ntl = nwin + (latent ? 4 : 0);
  const int skey = tid >> 2, sseg = tid & 3;
  bf16x8 wk0, wk1, wv0, wv1;
  float4 ckr[4], cvr[4];
#define AT_ISSUE(tt)                                                                              \
  {                                                                                               \
    if ((tt) < nwin) {                                                                            \
      const u16* src_ = z + (size_t)(tb + (kt0 + (tt)) * 64 + skey) * ZC + kvh * 64 + sseg * 16;  \
      wk0 = *(const bf16x8*)(src_ + AK);                                                          \
      wk1 = *(const bf16x8*)(src_ + AK + 8);                                                      \
      wv0 = *(const bf16x8*)(src_ + AV);                                                          \
      wv1 = *(const bf16x8*)(src_ + AV + 8);                                                      \
    } else if ((tt) < ntl) {                                                                      \
      int pk_ = ((tt) - nwin) * 64 + skey;                                                        \
      const float4* ck_ = (const float4*)(p.cache_k + ((size_t)(b * 2 + l) * 256 + pk_) * 128 + kvh * 64 + sseg * 16); \
      const float4* cv_ = (const float4*)(p.cache_v + ((size_t)(b * 2 + l) * 256 + pk_) * 128 + kvh * 64 + sseg * 16); \
      _Pragma("unroll") for (int i = 0; i < 4; ++i) {                                             \
        ckr[i] = ck_[i];                                                                          \
        cvr[i] = cv_[i];                                                                          \
      }                                                                                           \
    }                                                                                             \
  }
  AT_ISSUE(0);
  for (int ti = 0; ti < ntl; ++ti) {
    lds_barrier();
    const bool win = ti < nwin;
    if (win) {
      *(bf16x8*)(Ks + skey * 72 + sseg * 16) = wk0;
      *(bf16x8*)(Ks + skey * 72 + sseg * 16 + 8) = wk1;
      *(bf16x8*)(Vt + skey * 72 + sseg * 16) = wv0;
      *(bf16x8*)(Vt + skey * 72 + sseg * 16 + 8) = wv1;
    } else {
#pragma unroll
      for (int i = 0; i < 4; ++i) {
        float4 f = ckr[i];
        bf16x4 o;
        o[0] = (short)f2bf(f.x);
        o[1] = (short)f2bf(f.y);
        o[2] = (short)f2bf(f.z);
        o[3] = (short)f2bf(f.w);
        *(bf16x4*)(Ks + skey * 72 + sseg * 16 + i * 4) = o;
        float4 g = cvr[i];
        bf16x4 ov;
        ov[0] = (short)f2bf(g.x);
        ov[1] = (short)f2bf(g.y);
        ov[2] = (short)f2bf(g.z);
        ov[3] = (short)f2bf(g.w);
        *(bf16x4*)(Vt + skey * 72 + sseg * 16 + i * 4) = ov;
      }
    }
    lds_barrier();
    AT_ISSUE(ti + 1);
    int mstate = 0;
    if (win && latent) {
      const int kbase = (kt0 + ti) * 64;
      const int qlo = qb * 128 + w * 32, qhi = qlo + 31;
      if (kbase > qhi + 128 || kbase + 63 < qlo - 128)
        mstate = 2;
      else if (!(kbase >= qhi - 128 && kbase + 63 <= qlo + 128))
        mstate = 1;
    }
    if (mstate != 2) {
      f32x16 s[2];
#pragma unroll
      for (int mt = 0; mt < 2; ++mt) {
#pragma unroll
        for (int r = 0; r < 16; ++r) s[mt][r] = 0.f;
#pragma unroll
        for (int ks = 0; ks < 4; ++ks) {
          bf16x8 a = *(const bf16x8*)(Ks + (mt * 32 + ql) * 72 + ks * 16 + hh * 8);
          s[mt] = mfma32(a, qf[ks], s[mt]);
        }
      }
      const float SC = 0.125f * 1.4426950408889634f;
      float mx = -1e30f;
      if (mstate == 1) {
        const int kb0 = (kt0 + ti) * 64 + 4 * hh - qpos;
#pragma unroll
        for (int mt = 0; mt < 2; ++mt)
#pragma unroll
          for (int r = 0; r < 16; ++r) {
            int d = kb0 + mt * 32 + 8 * (r >> 2) + (r & 3);
            float v = s[mt][r] * SC;
            v = ((unsigned)(d + 128) > 256u) ? -1e30f : v;
            s[mt][r] = v;
            mx = fmaxf(mx, v);
          }
      } else {
#pragma unroll
        for (int mt = 0; mt < 2; ++mt)
#pragma unroll
          for (int r = 0; r < 16; ++r) {
            float v = s[mt][r] * SC;
            s[mt][r] = v;
            mx = fmaxf(mx, v);
          }
      }
      mx = fmaxf(mx, __shfl_xor(mx, 32));
      const float mn = fmaxf(m, mx);
      if (__any(mn > m)) {
        const float alpha = __builtin_amdgcn_exp2f(m - mn);
        lsum *= alpha;
#pragma unroll
        for (int d = 0; d < 2; ++d)
#pragma unroll
          for (int r = 0; r < 16; ++r) oacc[d][r] *= alpha;
      }
      m = mn;
      float ps = 0.f;
#pragma unroll
      for (int mt = 0; mt < 2; ++mt)
#pragma unroll
        for (int r = 0; r < 16; ++r) {
          float pv = __builtin_amdgcn_exp2f(s[mt][r] - mn);
          s[mt][r] = pv;
          ps += pv;
        }
      lsum += ps;
#pragma unroll
      for (int mt = 0; mt < 2; ++mt)
#pragma unroll
        for (int s2 = 0; s2 < 2; ++s2) {
          bf16x8 pb;
#pragma unroll
          for (int e = 0; e < 8; ++e) pb[e] = (short)f2bf(s[mt][8 * s2 + e]);
#pragma unroll
          for (int dt = 0; dt < 2; ++dt) {
            const u16* vp = Vt + (mt * 32 + s2 * 16 + 4 * hh + ((lane & 15) >> 2)) * 72 + dt * 32 + ((lane >> 4) & 1) * 16 +
                            (lane & 3) * 4;
            typedef __attribute__((address_space(3))) bf16x4 lds_b4;
            bf16x4 a0 = __builtin_amdgcn_ds_read_tr16_b64_v4i16((lds_b4*)vp);
            bf16x4 a1 = __builtin_amdgcn_ds_read_tr16_b64_v4i16((lds_b4*)(vp + 8 * 72));
            bf16x8 a = {a0[0], a0[1], a0[2], a0[3], a1[0], a1[1], a1[2], a1[3]};
            oacc[dt] = mfma32(a, pb, oacc[dt]);
          }
        }
    }
  }
  }
  float lt = lsum + __shfl_xor(lsum, 32);
  float inv = 1.f / lt;
#pragma unroll
  for (int dt = 0; dt < 2; ++dt)
#pragma unroll
    for (int r4 = 0; r4 < 4; ++r4) {
      int d0 = dt * 32 + 8 * r4 + 4 * hh;
      bf16x4 gg = *(const bf16x4*)(z + qrow * ZC + AG + head * 64 + d0);
      bf16x4 o;
#pragma unroll
      for (int k = 0; k < 4; ++k) o[k] = (short)f2bf(oacc[dt][r4 * 4 + k] * inv * silu(bfs(gg[k])));
      *(bf16x4*)(z + qrow * ZC + AQ + head * 64 + d0) = o;
    }
}

__device__ void sgu_item(const P& p, int l, int it, char* smem) {
  int tid = threadIdx.x;
  asm volatile("" : "+v"(tid));
  const int lane = tid & 63, w = tid >> 6, fr = lane & 15, fq = lane >> 4;
  const int ch = it >> 2, g = it & 3;
  const int t0 = ch * 128;
  u16* vgT = (u16*)smem;
  u16* z = (u16*)(p.ws + WS_Z);
  {
    int s = tid >> 1, half = tid & 1;
    const u16* vp = z + (size_t)(t0 + s) * ZC + BV + g * 64 + half * 32;
    float v[32];
#pragma unroll
    for (int i = 0; i < 4; ++i) {
      bf16x8 x = *(const bf16x8*)(vp + i * 8);
#pragma unroll
      for (int e = 0; e < 8; ++e) v[i * 8 + e] = bfs(x[e]);
    }
    float sm = 0.f;
#pragma unroll
    for (int i = 0; i < 32; ++i) sm += v[i];
    sm += __shfl_xor(sm, 1);
    float mean = sm * (1.f / 64.f);
    float vs = 0.f;
#pragma unroll
    for (int i = 0; i < 32; ++i) {
      float d = v[i] - mean;
      vs += d * d;
    }
    vs += __shfl_xor(vs, 1);
    float rstd = rsqrtf(vs * (1.f / 64.f) + EPS);
    const float* lg = p.ln_g + l * 256 + g * 64 + half * 32;
    const float* lb = p.ln_b + l * 256 + g * 64 + half * 32;
#pragma unroll
    for (int i = 0; i < 32; ++i) {
      float y = (v[i] - mean) * rstd * lg[i] + lb[i];
      vgT[(half * 32 + i) * 136 + s] = f2bf(y);
    }
  }
  lds_barrier();
  const u16* W = (const u16*)(p.ws + WS_SGUW) + (size_t)(l * 4 + g) * 128 * 128;
  f32x4 acc[4][2];
#pragma unroll
  for (int i = 0; i < 4; ++i)
#pragma unroll
    for (int j = 0; j < 2; ++j) acc[i][j] = f32x4{0.f, 0.f, 0.f, 0.f};
#pragma unroll
  for (int ks = 0; ks < 4; ++ks) {
    bf16x8 a[4];
#pragma unroll
    for (int mi = 0; mi < 4; ++mi) a[mi] = *(const bf16x8*)(vgT + (mi * 16 + fr) * 136 + ks * 32 + fq * 8);
#pragma unroll
    for (int nj = 0; nj < 2; ++nj) {
      int t = (w * 2 + nj) * 16 + fr;
      bf16x8 bb = *(const bf16x8*)(W + t * 128 + ks * 32 + fq * 8);
#pragma unroll
      for (int mi = 0; mi < 4; ++mi) acc[mi][nj] = mfma16(a[mi], bb, acc[mi][nj]);
    }
  }
#pragma unroll
  for (int nj = 0; nj < 2; ++nj) {
    int t = (w * 2 + nj) * 16 + fr;
    float bs = p.sgu_b[(l * 4 + g) * 128 + t];
    u16* zr = z + (size_t)(t0 + t) * ZC;
#pragma unroll
    for (int mi = 0; mi < 4; ++mi) {
      int c0 = g * 64 + mi * 16 + fq * 4;
      bf16x4 uu = *(const bf16x4*)(zr + BU + c0), gg = *(const bf16x4*)(zr + BG + c0);
      bf16x4 o;
#pragma unroll
      for (int r = 0; r < 4; ++r) o[r] = (short)f2bf(bfs(uu[r]) * (acc[mi][nj][r] + bs) * silu(bfs(gg[r])));
      *(bf16x4*)(zr + BU + c0) = o;
    }
  }
}

__device__ void gdnpre_item(const P& p, int l, int it, char* smem) {
  int tid = threadIdx.x;
  asm volatile("" : "+v"(tid));
  const int lane = tid & 63, w = tid >> 6, fr = lane & 15, fq = lane >> 4;
  const int cgi = it >> 2, h = it & 3;
  const int tok0 = cgi * 64;
  int T, pos0;
  if (tok0 < NCTX) {
    T = 256;
    pos0 = tok0 & 255;
  } else {
    T = 4096;
    pos0 = (tok0 - NCTX) & 4095;
  }
  u16* z = (u16*)(p.ws + WS_Z);
  u16* raw = (u16*)smem;
  float* Amat = (float*)smem;
  u16* kn_s = (u16*)(smem + 33280);
  u16* qn_s = kn_s + 4608;
  u16* vT_s = (u16*)(smem + 51712);
  u16* knT_s = vT_s + 4608;
  float* gt = (float*)(smem + 70144);
  float* bt = gt + 128;
  float* glv = bt + 128;
  float* glbuf = (float*)(p.ws + WS_GL);
  float* cw_s = (float*)(smem + 71200);
  {
    bf16x8 rv[7];
    float cwv[4];
    u16 ga = 0, gb = 0;
#pragma unroll
    for (int i = 0; i < 7; ++i) {
      int e = tid + 256 * i;
      int r = e / 24, sg = e % 24;
      int pp = pos0 - 2 + r;
      rv[i] = bf16x8{0, 0, 0, 0, 0, 0, 0, 0};
      if (e < 68 * 24 && pp >= 0 && pp < T) {
        int m = sg >> 3, o = (sg & 7) * 8;
        rv[i] = *(const bf16x8*)(z + (size_t)(tok0 - 2 + r) * ZC + CQ + m * 256 + h * 64 + o);
      }
    }
#pragma unroll
    for (int i = 0; i < 4; ++i) {
      int e = tid + 256 * i;
      int tap = e / 192, ch = e % 192;
      cwv[i] = 0.f;
      if (e < 960) cwv[i] = p.conv_w[(size_t)(l * 5 + tap) * 768 + (ch >> 6) * 256 + h * 64 + (ch & 63)];
    }
    if (tid < 128) {
      const u16* zr = z + (size_t)(tok0 + (tid & 63)) * ZC;
      ga = zr[CA + (tid >> 6) * 4 + h];
      gb = zr[CB + (tid >> 6) * 4 + h];
    }
#pragma unroll
    for (int i = 0; i < 7; ++i) {
      int e = tid + 256 * i;
      if (e < 68 * 24) *(bf16x8*)(raw + (e / 24) * 192 + (e % 24) * 8) = rv[i];
    }
#pragma unroll
    for (int i = 0; i < 4; ++i) {
      int e = tid + 256 * i;
      if (e < 960) cw_s[e] = cwv[i];
    }
    if (tid < 128) {
      int dir = tid >> 6, t = tid & 63;
      float a = bf2f(ga);
      float bl = bf2f(gb);
      float xx = a + p.dt_bias[(l * 2 + dir) * 4 + h];
      float sp = xx > 20.f ? xx : log1pf(expf(xx));
      gt[dir * 64 + t] = -expf(p.a_log[(l * 2 + dir) * 4 + h]) * sp;
      bt[dir * 64 + t] = 1.f / (1.f + expf(-bl));
    }
  }
  lds_barrier();
  const int t = tid >> 2, q4 = tid & 3;
  float qv[16], kv[16], vv[16];
  {
#pragma unroll
    for (int i = 0; i < 16; ++i) {
      qv[i] = 0.f;
      kv[i] = 0.f;
      vv[i] = 0.f;
    }
#pragma unroll 1
    for (int tap = 0; tap < 5; ++tap) {
      const u16* rr = raw + (t + tap) * 192 + q4 * 16;
      const float* cwt = cw_s + tap * 192 + q4 * 16;
#pragma unroll
      for (int i = 0; i < 16; ++i) {
        qv[i] += cwt[i] * bf2f(rr[i]);
        kv[i] += cwt[64 + i] * bf2f(rr[64 + i]);
        vv[i] += cwt[128 + i] * bf2f(rr[128 + i]);
      }
    }
#pragma unroll
    for (int i = 0; i < 16; ++i) {
      qv[i] = silu(qv[i]);
      kv[i] = silu(kv[i]);
      vv[i] = silu(vv[i]);
    }
    float sq = 0.f, sk = 0.f;
#pragma unroll
    for (int i = 0; i < 16; ++i) {
      sq += qv[i] * qv[i];
      sk += kv[i] * kv[i];
    }
    sq += __shfl_xor(sq, 1);
    sq += __shfl_xor(sq, 2);
    sk += __shfl_xor(sk, 1);
    sk += __shfl_xor(sk, 2);
    float rq = rsqrtf(sq + EPS) * 0.125f, rk = rsqrtf(sk + EPS);
#pragma unroll
    for (int i = 0; i < 16; ++i) {
      qv[i] *= rq;
      kv[i] *= rk;
    }
  }
  if (w < 2) {
    const int tt = w ? 63 - lane : lane;
    float v = gt[w * 64 + tt];
#pragma unroll
    for (int o = 1; o < 64; o <<= 1) {
      float u = __shfl_up(v, o);
      if (lane >= o) v += u;
    }
    gt[w * 64 + tt] = v;
    if (lane == 63) glv[w] = v;
  }
  lds_barrier();
  unsigned boff = (unsigned)it * 40960u;
  LAUNDER(boff);
  u16* base = (u16*)(p.ws + WS_R3) + boff;
  {
    float gc0 = gt[t], gc1 = gt[64 + t], gl0 = glv[0], gl1 = glv[1];
    float e0 = __expf(gc0), e1 = __expf(gc1), f0 = __expf(gl0 - gc0), f1 = __expf(gl1 - gc1);
    u16* q0 = base + 1 * 4096 + t * 64;
    u16* q1 = base + 5 * 4096 + 1 * 4096 + (63 - t) * 64;
    u16* kd0 = base + 3 * 4096 + q4 * 1024 + permg(t & 60) + (t & 3);
    u16* kd1 = base + 5 * 4096 + 3 * 4096 + q4 * 1024 + permg((63 - t) & 60) + ((63 - t) & 3);
    const int qg0 = permg(q4 * 16), qg1 = permg(q4 * 16 + 4), qg2 = permg(q4 * 16 + 8), qg3 = permg(q4 * 16 + 12);
    bf16x8 kpk[2], qpk[2], vpk[2];
#pragma unroll
    for (int i = 0; i < 16; ++i) {
      int d = q4 * 16 + i;
      u16 kb = f2bf(kv[i]);
      kpk[i >> 3][i & 7] = (short)kb;
      qpk[i >> 3][i & 7] = (short)f2bf(qv[i]);
      vpk[i >> 3][i & 7] = (short)f2bf(vv[i]);
      (void)d;
      const int qc = ((i >> 2) == 0 ? qg0 : (i >> 2) == 1 ? qg1 : (i >> 2) == 2 ? qg2 : qg3) + (i & 3);
      q0[qc] = f2bf(qv[i] * e0);
      q1[qc] = f2bf(qv[i] * e1);
      kd0[i * 64] = f2bf(kv[i] * f0);
      kd1[i * 64] = f2bf(kv[i] * f1);
    }
#pragma unroll
    for (int hf = 0; hf < 2; ++hf) {
      *(bf16x8*)(kn_s + t * 72 + q4 * 16 + hf * 8) = kpk[hf];
      *(bf16x8*)(qn_s + t * 72 + q4 * 16 + hf * 8) = qpk[hf];
      *(bf16x8*)(vT_s + t * 72 + q4 * 16 + hf * 8) = vpk[hf];
      *(bf16x8*)(knT_s + t * 72 + q4 * 16 + hf * 8) = kpk[hf];
    }
    if (tid == 0) {
      glbuf[it * 2] = gl0;
      glbuf[it * 2 + 1] = gl1;
    }
  }
  lds_barrier();
  {
    f32x4 c1[4], c2[4];
#pragma unroll
    for (int i = 0; i < 4; ++i) {
      c1[i] = f32x4{0.f, 0.f, 0.f, 0.f};
      c2[i] = f32x4{0.f, 0.f, 0.f, 0.f};
    }
#pragma unroll
    for (int ks = 0; ks < 2; ++ks) {
      bf16x8 a = *(const bf16x8*)(kn_s + (w * 16 + fr) * 72 + ks * 32 + fq * 8);
#pragma unroll
      for (int ni = 0; ni < 4; ++ni) {
        bf16x8 bq = *(const bf16x8*)(qn_s + (ni * 16 + fr) * 72 + ks * 32 + fq * 8);
        bf16x8 bk = *(const bf16x8*)(kn_s + (ni * 16 + fr) * 72 + ks * 32 + fq * 8);
        c1[ni] = mfma16(a, bq, c1[ni]);
        c2[ni] = mfma16(a, bk, c2[ni]);
      }
    }
    lds_barrier();
    LAUNDER(boff);
    base = (u16*)(p.ws + WS_R3) + boff;
#pragma unroll
    for (int ni = 0; ni < 4; ++ni) {
      int i = ni * 16 + fr;
      float gi0 = gt[i], gi1 = gt[64 + i], bi0 = bt[i], bi1 = bt[64 + i];
      int j0 = w * 16 + fq * 4;
      bf16x4 a0, a1;
#pragma unroll
      for (int r = 0; r < 4; ++r) {
        int j = j0 + r;
        float gj0 = gt[j], gj1 = gt[64 + j];
        float d0 = (i >= j) ? __expf(gi0 - gj0) : 0.f;
        float d1 = (i <= j) ? __expf(gi1 - gj1) : 0.f;
        a0[r] = (short)f2bf(c1[ni][r] * d0);
        a1[3 - r] = (short)f2bf(c1[ni][r] * d1);
        Amat[i * 65 + j] = (i > j) ? bi0 * c2[ni][r] * d0 : 0.f;
        Amat[4160 + (63 - i) * 65 + (63 - j)] = (i < j) ? bi1 * c2[ni][r] * d1 : 0.f;
      }
      *(bf16x4*)(base + 2 * 4096 + i * 64 + permg(j0)) = a0;
      *(bf16x4*)(base + 5 * 4096 + 2 * 4096 + (63 - i) * 64 + permg(60 - j0)) = a1;
    }
  }
  lds_barrier();
  if (w < 2) {
    float* Am = Amat + w * 4160;
    const int g = fq, c = fr;
    {
      float t[16];
      const float* Ab = Am + (g * 16) * 65 + g * 16;
#pragma unroll
      for (int i = 0; i < 16; ++i) {
        float acc = (i == c) ? 1.f : 0.f;
#pragma unroll
        for (int j = 0; j < i; ++j) acc -= Ab[i * 65 + j] * t[j];
        t[i] = acc;
      }
      float* Tw = Am + (g * 16) * 65 + g * 16 + c;
#pragma unroll
      for (int i = 0; i < 16; ++i) Tw[i * 65] = t[i];
    }
    for (int I = 1; I < 4; ++I)
      for (int J = 0; J < I; ++J) {
        f32x4 M = {0.f, 0.f, 0.f, 0.f};
        for (int K = J; K < I; ++K) {
#pragma unroll
          for (int s = 0; s < 4; ++s) {
            float a = Am[(I * 16 + fr) * 65 + K * 16 + 4 * s + g];
            float bb = Am[(K * 16 + 4 * s + g) * 65 + J * 16 + fr];
            M = __builtin_amdgcn_mfma_f32_16x16x4f32(a, bb, M, 0, 0, 0);
          }
        }
        f32x4 X = {0.f, 0.f, 0.f, 0.f};
#pragma unroll
        for (int s = 0; s < 4; ++s) {
          float a = Am[(I * 16 + fr) * 65 + I * 16 + 4 * g + s];
          X = __builtin_amdgcn_mfma_f32_16x16x4f32(a, M[s], X, 0, 0, 0);
        }
#pragma unroll
        for (int r = 0; r < 4; ++r) Am[(I * 16 + 4 * g + r) * 65 + J * 16 + fr] = -X[r];
      }
  }
  for (int dir = 0; dir < 2; ++dir) {
    u16* Tb = kn_s;
    u16* Tbg = kn_s + 4608;
    lds_barrier();
    LAUNDER(boff);
    base = (u16*)(p.ws + WS_R3) + boff;
    u16* bd = base + dir * 5 * 4096;
    for (int e = tid; e < 4096; e += 256) {
      int i = e >> 6, c = e & 63;
      float tv = Amat[dir * 4160 + i * 65 + c];
      if (dir == 0) {
        float bc = bt[c];
        float bg = bc * __expf(gt[c]);
        Tb[i * 72 + c] = f2bf(tv * bc);
        Tbg[i * 72 + c] = f2bf(tv * bg);
      } else {
        int tc = 63 - c;
        float bc = bt[64 + tc];
        float bg = bc * __expf(gt[64 + tc]);
        Tb[(63 - i) * 72 + tc] = f2bf(tv * bc);
        Tbg[(63 - i) * 72 + tc] = f2bf(tv * bg);
      }
    }
    lds_barrier();
    f32x4 cu[4], cw[4];
#pragma unroll
    for (int i = 0; i < 4; ++i) {
      cu[i] = f32x4{0.f, 0.f, 0.f, 0.f};
      cw[i] = f32x4{0.f, 0.f, 0.f, 0.f};
    }
#pragma unroll
    for (int ks = 0; ks < 2; ++ks) {
      bf16x8 aT = *(const bf16x8*)(Tb + (w * 16 + fr) * 72 + ks * 32 + fq * 8);
      typedef __attribute__((address_space(3))) bf16x4 lds_b4;
      const int trow = ks * 32 + fq * 8 + (fr >> 2), tcol = (fr & 3) * 4;
      bf16x8 aK;
      {
        const u16* sp = knT_s + trow * 72 + w * 16 + tcol;
        bf16x4 l4 = __builtin_amdgcn_ds_read_tr16_b64_v4i16((lds_b4*)sp);
        bf16x4 h4 = __builtin_amdgcn_ds_read_tr16_b64_v4i16((lds_b4*)(sp + 4 * 72));
        aK = bf16x8{l4[0], l4[1], l4[2], l4[3], h4[0], h4[1], h4[2], h4[3]};
      }
#pragma unroll
      for (int ni = 0; ni < 4; ++ni) {
        bf16x8 bv;
        {
          const u16* sp = vT_s + trow * 72 + ni * 16 + tcol;
          bf16x4 l4 = __builtin_amdgcn_ds_read_tr16_b64_v4i16((lds_b4*)sp);
          bf16x4 h4 = __builtin_amdgcn_ds_read_tr16_b64_v4i16((lds_b4*)(sp + 4 * 72));
          bv = bf16x8{l4[0], l4[1], l4[2], l4[3], h4[0], h4[1], h4[2], h4[3]};
        }
        bf16x8 bT = *(const bf16x8*)(Tbg + (ni * 16 + fr) * 72 + ks * 32 + fq * 8);
        cu[ni] = mfma16(aT, bv, cu[ni]);
        cw[ni] = mfma16(aK, bT, cw[ni]);
      }
    }
#pragma unroll
    for (int ni = 0; ni < 4; ++ni) {
      int d = ni * 16 + fr;
      int i0 = w * 16 + fq * 4;
      bf16x4 o;
      if (dir == 0) {
#pragma unroll
        for (int r = 0; r < 4; ++r) o[r] = (short)f2bf(cu[ni][r]);
        *(bf16x4*)(bd + 4 * 4096 + d * 64 + i0) = o;
      } else {
#pragma unroll
        for (int r = 0; r < 4; ++r) o[3 - r] = (short)f2bf(cu[ni][r]);
        *(bf16x4*)(bd + 4 * 4096 + d * 64 + 60 - i0) = o;
      }
      int i = ni * 16 + fr;
      int pp = dir ? 63 - i : i;
      int d0 = w * 16 + fq * 4;
      bf16x4 o2;
#pragma unroll
      for (int r = 0; r < 4; ++r) o2[r] = (short)f2bf(cw[ni][r]);
      *(bf16x4*)(bd + 0 * 4096 + pp * 64 + permg(d0)) = o2;
    }
  }
}

DEVI bf16x8 ldA(const u16* M, int mi, int ks, int fr, int fq) {
  const u16* q = M + (mi * 16 + fr) * 64 + ks * 32 + fq * 4;
  bf16x4 lo = *(const bf16x4*)q, hi = *(const bf16x4*)(q + 16);
  return bf16x8{lo[0], lo[1], lo[2], lo[3], hi[0], hi[1], hi[2], hi[3]};
}

DEVI bf16x8 ldL(const char* smem, int mat, int mi, int ks, int fr, int fq) {
  return *(const bf16x8*)(smem + (mat * 64 + mi * 16 + fr) * 144 + (ks * 32 + fq * 8) * 2);
}

__device__ void scan_item(const P& p, int l, int id, char* smem) {
  int tid = threadIdx.x;
  asm volatile("" : "+v"(tid));
  const int lane = tid & 63, w = tid >> 6, fr = lane & 15, fq = lane >> 4;
  const int latent = id < 64;
  const int cid = latent ? id : id - 64;
  const int b = cid >> 3, h = (cid >> 1) & 3, dir = cid & 1;
  const int tb = latent ? NCTX + b * 4096 : b * 256;
  const int N = latent ? 64 : 4;
  u16* z = (u16*)(p.ws + WS_Z);
  const float* glbuf = (const float*)(p.ws + WS_GL);
  const unsigned char* r3 = p.ws + WS_R3;
  f32x4 S[4];
  if (latent) {
    const float* s0 = p.state + ((size_t)(((b * 2 + l) * 2 + dir) * 4 + h)) * 4096;
#pragma unroll
    for (int mt = 0; mt < 4; ++mt)
#pragma unroll
      for (int r = 0; r < 4; ++r) S[mt][r] = s0[(mt * 16 + fq * 4 + r) * 64 + w * 16 + fr];
  } else {
#pragma unroll
    for (int mt = 0; mt < 4; ++mt) S[mt] = f32x4{0.f, 0.f, 0.f, 0.f};
  }
  __builtin_amdgcn_s_setprio(3);
  float eglv;
  {
    const int nn = lane < N ? lane : N - 1;
    const int cidx_ = dir ? N - 1 - nn : nn;
    const int it_ = ((tb + cidx_ * 64) >> 6) * 4 + h;
    eglv = __expf(glbuf[it_ * 2 + dir]);
  }
  bf16x8 R0[10], R1[10];
#define SC_ISSUE(R, nn)                                                      \
  {                                                                          \
    int n_ = (nn) < N ? (nn) : N - 1;                                        \
    int cidx_ = dir ? N - 1 - n_ : n_;                                       \
    int it_ = ((tb + cidx_ * 64) >> 6) * 4 + h;                              \
    const unsigned char* g_ = r3 + (size_t)(it_ * 2 + dir) * 40960 + tid * 16; \
    _Pragma("unroll") for (int j = 0; j < 10; ++j) R[j] = *(const bf16x8*)(g_ + j * 4096); \
  }
#define SC_STASH(R)                                                          \
  {                                                                          \
    _Pragma("unroll") for (int j = 0; j < 10; ++j) {                         \
      int c_ = tid + 256 * j;                                                \
      *(bf16x8*)(smem + (c_ >> 3) * 144 + (c_ & 7) * 16) = R[j];             \
    }                                                                        \
  }
  SC_ISSUE(R0, 0);
  SC_ISSUE(R1, 1);
  for (int n2 = 0; n2 < N; n2 += 2) {
#pragma unroll
    for (int half = 0; half < 2; ++half) {
      const int n = n2 + half;
      lds_barrier();
      if (half == 0) { SC_STASH(R0); } else { SC_STASH(R1); }
      lds_barrier();
      if (half == 0) { SC_ISSUE(R0, n + 2); } else { SC_ISSUE(R1, n + 2); }
      const int cidx = dir ? N - 1 - n : n;
      const int tok0 = tb + cidx * 64;
      const int it = (tok0 >> 6) * 4 + h;
      const float egl = __shfl(eglv, n);
      bf16x8 Sb[2];
#pragma unroll
      for (int ks = 0; ks < 2; ++ks)
#pragma unroll
        for (int e = 0; e < 8; ++e) Sb[ks][e] = (short)f2bf(S[2 * ks + (e >> 2)][e & 3]);
      f32x4 vn[4];
#pragma unroll
      for (int mi = 0; mi < 4; ++mi) {
        f32x4 acc = {0.f, 0.f, 0.f, 0.f};
#pragma unroll
        for (int ks = 0; ks < 2; ++ks) acc = mfma16(ldL(smem, 0, mi, ks, fr, fq), Sb[ks], acc);
        bf16x4 uu = *(const bf16x4*)(smem + (256 + w * 16 + fr) * 144 + (mi * 16 + fq * 4) * 2);
#pragma unroll
        for (int r = 0; r < 4; ++r) vn[mi][r] = bfs(uu[r]) - acc[r];
      }
      bf16x8 Vb[2];
#pragma unroll
      for (int ks = 0; ks < 2; ++ks)
#pragma unroll
        for (int e = 0; e < 8; ++e) Vb[ks][e] = (short)f2bf(vn[2 * ks + (e >> 2)][e & 3]);
#pragma unroll
      for (int mt = 0; mt < 4; ++mt) {
        f32x4 acc = S[mt] * egl;
#pragma unroll
        for (int ks = 0; ks < 2; ++ks) acc = mfma16(ldL(smem, 3, mt, ks, fr, fq), Vb[ks], acc);
        S[mt] = acc;
      }
      {
        const int colo = (dir ? CV : CK) + h * 64 + w * 16 + fq * 4;
        u16* zo = z + (size_t)(tok0 + (dir ? 63 - fr : fr)) * ZC + colo;
        const int rstep = dir ? -ZC : ZC;
#pragma unroll
        for (int mi = 0; mi < 4; ++mi) {
          f32x4 acc = {0.f, 0.f, 0.f, 0.f};
#pragma unroll
          for (int ks = 0; ks < 2; ++ks) acc = mfma16(Sb[ks], ldL(smem, 1, mi, ks, fr, fq), acc);
#pragma unroll
          for (int ks = 0; ks < 2; ++ks) acc = mfma16(Vb[ks], ldL(smem, 2, mi, ks, fr, fq), acc);
          bf16x4 o4;
#pragma unroll
          for (int r = 0; r < 4; ++r) o4[r] = (short)f2bf(acc[r]);
          *(bf16x4*)(zo + (mi * 16) * rstep) = o4;
        }
      }
    }
  }
#undef SC_ISSUE
#undef SC_STASH
  __builtin_amdgcn_s_setprio(0);
  if (!latent) {
    float* dst = p.out + OFF_ST + ((size_t)(((b * 2 + l) * 2 + dir) * 4 + h)) * 4096;
#pragma unroll
    for (int mt = 0; mt < 4; ++mt)
#pragma unroll
      for (int r = 0; r < 4; ++r) dst[(mt * 16 + fq * 4 + r) * 64 + w * 16 + fr] = S[mt][r];
  }
}

__device__ void fin_phase(const P& p, int l) {
  int tid = threadIdx.x;
  asm volatile("" : "+v"(tid));
  const int lane = tid & 63, wv = tid >> 6;
  u16* z = (u16*)(p.ws + WS_Z);
  const int c = lane * 4;
  float ngv[4];
#pragma unroll
  for (int k = 0; k < 4; ++k) ngv[k] = p.norm_g[l * 64 + (c & 63) + k];
  for (int it = blockIdx.x; it < 1280; it += gridDim.x) {
    const int row0 = it * 32 + wv * 8;
    bf16x4 of[8], ob[8], cg4[8];
#pragma unroll
    for (int rr = 0; rr < 8; ++rr) {
      const u16* zr = z + (size_t)(row0 + rr) * ZC;
      of[rr] = *(const bf16x4*)(zr + CK + c);
      ob[rr] = *(const bf16x4*)(zr + CV + c);
      cg4[rr] = *(const bf16x4*)(zr + CG + c);
    }
#pragma unroll
    for (int rr = 0; rr < 8; ++rr) {
      float o[4];
      float ss = 0.f;
#pragma unroll
      for (int k = 0; k < 4; ++k) {
        o[k] = bfs(of[rr][k]) + bfs(ob[rr][k]);
        ss += o[k] * o[k];
      }
      ss += __shfl_xor(ss, 1);
      ss += __shfl_xor(ss, 2);
      ss += __shfl_xor(ss, 4);
      ss += __shfl_xor(ss, 8);
      float rstd = rsqrtf(ss * (1.f / 64.f) + EPS);
      bf16x4 ov;
#pragma unroll
      for (int k = 0; k < 4; ++k) ov[k] = (short)f2bf(o[k] * rstd * ngv[k] * silu(bfs(cg4[rr][k])));
      *(bf16x4*)(z + (size_t)(row0 + rr) * ZC + CQ + c) = ov;
    }
  }
}

__device__ void mixed_phase(const P& p, int l, char* smem, int mask) {
  int* ctr = (int*)(p.ws + WS_CTR);
  int* sitem = (int*)(smem + SITEM_OFF);
  const int x0 = (int)(xb_xcc_id() & 7u);
  for (int dx = 0; dx < 8; ++dx) {
    const int x = (x0 + dx) & 7;
    int* c = ctr + (l * 8 + x) * 16;
    for (;;) {
      __syncthreads();
      if (threadIdx.x == 0) *sitem = atomicAdd(c, 1);
      __syncthreads();
      const int j = __builtin_amdgcn_readfirstlane(*sitem);
      if (j >= 520) break;
      if (j < 8)
        scan_item(p, l, x * 8 + j, smem);
      else if (j < 40)
        scan_item(p, l, 64 + x * 32 + (j - 8), smem);
      else if (j < 296)
        attn_item(p, l, x * 256 + (j - 40), smem, ((mask >> 9) & 1) ? 2 : 1);
      else if (j < 360)
        attn_item(p, l, 2048 + x * 64 + (j - 296), smem, ((mask >> 9) & 1) ? 2 : 1);
      else
        sgu_item(p, l, x * 160 + (j - 360), smem);
    }
  }
}

__device__ void run_phase(const P& p, int ph, char* smem, int mask) {
  if (ph == 0) {
    phase0(p, smem);
  } else if (ph == 1) {
    row_phase(p, 0);
  } else {
    int l = (ph - 2) / 6, s = (ph - 2) % 6;
    if (s == 0)
      gemm_phase<0>(p, l, smem);
    else if (s == 1) {
      for (int it = blockIdx.x; it < 2560; it += gridDim.x) {
        __syncthreads();
        gdnpre_item(p, l, it, smem);
      }
    } else if (s == 2)
      mixed_phase(p, l, smem, mask);
    else if (s == 3)
      fin_phase(p, l);
    else if (s == 4)
      gemm_phase<1>(p, l, smem);
    else
      row_phase(p, 1 + l);
  }
}

__global__ void __launch_bounds__(256, 2) mega(P p, int ph0, int ph1, int mask) {
  extern __shared__ __align__(16) char smem[];
  volatile LAS unsigned* st = (volatile LAS unsigned*)(smem + XBST_OFF);
  if (threadIdx.x == 0) {
    st[0] = 0u;
    st[1] = 0u;
  }
  __syncthreads();
  XcdBarrier xb = xcd_barrier_post((unsigned*)(p.ws + WS_BAR), st);
  if (mask == 0x40000000) cg::this_grid().sync();
  for (int ph = ph0; ph < ph1; ++ph) {
    int s_ = ph < 2 ? 6 + ph : (ph - 2) % 6;
    int reps = (((mask >> s_) & 1) && ph != 13) ? 2 : 1;
    for (int r = 0; r < reps; ++r) {
      run_phase(p, ph, smem, mask);
      if (r + 1 < reps || ph + 1 < ph1) xcd_barrier(xb);
    }
  }
}

extern "C" void kernel_launch(void* const* d_in, const int* in_sizes, int n_in, void* d_out, int out_size, void* d_ws,
                              size_t ws_size, hipStream_t stream) {
  static int grid_blocks = 0;
  if (!grid_blocks) {
    hipFuncSetAttribute((const void*)mega, hipFuncAttributeMaxDynamicSharedMemorySize, SMEM_BYTES);
    int dev = 0, cus = 0, per_cu = 0;
    hipGetDevice(&dev);
    hipDeviceGetAttribute(&cus, hipDeviceAttributeMultiprocessorCount, dev);
    hipOccupancyMaxActiveBlocksPerMultiprocessor(&per_cu, mega, 256, SMEM_BYTES);
    if (per_cu < 1) per_cu = 1;
    if (per_cu > 2) per_cu = 2;
    grid_blocks = cus * per_cu;
    if (ws_size < WS_END + 16384) fprintf(stderr, "workspace too small: %zu < %zu\n", ws_size, (size_t)WS_END);
  }
  P p{};
  const float** pp = (const float**)&p;
  for (int i = 0; i < 22; ++i) pp[i] = (const float*)d_in[i];
  p.out = (float*)d_out;
  p.ws = (unsigned char*)d_ws;
  hipMemsetAsync(d_ws, 0, 4096, stream);
  hipMemsetAsync((char*)d_ws + WS_BAR, 0, 16384, stream);
  const int NPH = 14;
#if ONE_LAUNCH
  int ph0 = 0, ph1 = NPH;
  int mask = PROBE_MASK;
  void* args[] = {&p, &ph0, &ph1, &mask};
  static int tried2 = 0;
  hipError_t e;
  if (!tried2) {
    tried2 = 1;
    int dev = 0, cus = 0;
    hipGetDevice(&dev);
    hipDeviceGetAttribute(&cus, hipDeviceAttributeMultiprocessorCount, dev);
    if (grid_blocks < cus * 2) {
      e = hipLaunchCooperativeKernel((const void*)mega, dim3(cus * 2), dim3(256), args, SMEM_BYTES, stream);
      if (e == hipSuccess) {
        grid_blocks = cus * 2;
        return;
      }
      (void)hipGetLastError();
    }
  }
  e = hipLaunchCooperativeKernel((const void*)mega, dim3(grid_blocks), dim3(256), args, SMEM_BYTES, stream);
  if (e != hipSuccess) fprintf(stderr, "cooperative launch failed: %s (grid %d)\n", hipGetErrorString(e), grid_blocks);
#else
  for (int ph = 0; ph < NPH; ++ph) mega<<<grid_blocks, 256, SMEM_BYTES, stream>>>(p, ph, ph + 1, 0);
#endif
}
```
